# Optimizing an MI355X kernel written in HIP

```python
import jax, jax.numpy as jnp
from jax import lax
import numpy as np

D_MODEL = 2048
BATCH = 1
SEQ = 16384
DEPTH = 2

HEAD_DIM = 128
D_MIX = D_MODEL
SGU_WIDTH = D_MIX // 2
SGU_GROUPS = SGU_WIDTH // HEAD_DIM
SGU_CHUNK = 128
ATT_WIDTH = D_MIX - SGU_WIDTH
ATT_HEADS = ATT_WIDTH // HEAD_DIM
DILATED_PATTERNS = ((128, 1), (512, 4), (2048, 16))
ATT_BLOCK = 128
ROPE_THETA = 500000.0
ROPE_DIM = HEAD_DIM // 4
D_IN = 2 * SGU_WIDTH + 3 * ATT_WIDTH
N_EXPERTS = 64
TOP_K = 8
N_GROUPS = 8
TOPK_GROUPS = 4
EXPERT_DIM = 512
SHARED_DIM = 512
ROUTED_SCALE = 2.5
MOE_BLOCK = 256
NORM_EPS = 1e-6
N_MOD = 6

kernel_name = "hybrid_sgu_dilated_moe_block"


def rms_norm(x, gain):
    x32 = x.astype(jnp.float32)
    y = x32 * lax.rsqrt(jnp.mean(x32 * x32, axis=-1, keepdims=True) + NORM_EPS)
    return (y * gain.astype(jnp.float32)).astype(x.dtype)


def partial_rope(x, pos):
    half = ROPE_DIM // 2
    inv = ROPE_THETA ** (-jnp.arange(half, dtype=jnp.float32) * 2.0 / ROPE_DIM)
    ang = pos.astype(jnp.float32)[:, None] * inv[None, :]
    cos, sin = jnp.cos(ang), jnp.sin(ang)
    x32 = x.astype(jnp.float32)
    x1, x2, rest = x32[..., :half], x32[..., half:ROPE_DIM], x32[..., ROPE_DIM:]
    out = jnp.concatenate([x1 * cos - x2 * sin, x2 * cos + x1 * sin, rest], axis=-1)
    return out.astype(x.dtype)


def chunked_spatial_gating(uv, norm_gain, w_s, b_s):
    b, s, _ = uv.shape
    z = jax.nn.gelu(uv, approximate=False)
    u, v = jnp.split(z, 2, axis=-1)
    v = rms_norm(v.reshape(b, s, SGU_GROUPS, HEAD_DIM), norm_gain.reshape(SGU_GROUPS, HEAD_DIM))
    v = v.reshape(b, s // SGU_CHUNK, SGU_CHUNK, SGU_GROUPS, HEAD_DIM)
    causal = jnp.tril(jnp.ones((SGU_CHUNK, SGU_CHUNK), dtype=bool))
    w = jnp.where(causal[None], w_s, 0).astype(v.dtype)
    mixed = jnp.einsum('gij,bnjgc->bnigc', w, v) + b_s.T[None, None, :, :, None].astype(v.dtype)
    return u * mixed.reshape(b, s, SGU_WIDTH)


def dilated_window_attention(q, k, v, window, dilation):
    b, h, s, dh = q.shape
    span = window // dilation
    sub_len = s // dilation
    nb = -(-sub_len // ATT_BLOCK)
    pad = nb * ATT_BLOCK - sub_len

    def to_blocks(t):
        t = t.reshape(b, h, sub_len, dilation, dh).transpose(0, 1, 3, 2, 4)
        t = jnp.pad(t, ((0, 0), (0, 0), (0, 0), (0, pad), (0, 0)))
        return t.reshape(b, h, dilation, nb, ATT_BLOCK, dh)

    def with_prev(t):
        prev = jnp.pad(t[:, :, :, :-1], ((0, 0), (0, 0), (0, 0), (1, 0), (0, 0), (0, 0)))
        return jnp.concatenate([prev, t], axis=-2)

    qb = to_blocks(q)
    kk = with_prev(to_blocks(k))
    vv = with_prev(to_blocks(v))
    scores = jnp.einsum('bhrnqd,bhrnkd->bhrnqk', qb, kk,
                        preferred_element_type=jnp.float32) * (dh ** -0.5)
    qi = jnp.arange(ATT_BLOCK)[:, None]
    kj = jnp.arange(2 * ATT_BLOCK)[None, :]
    dist = qi + ATT_BLOCK - kj
    blk = jnp.arange(nb)[:, None, None]
    valid = (dist >= 0) & (dist <= span) & (blk * ATT_BLOCK - ATT_BLOCK + kj >= 0)
    scores = jnp.where(valid, scores, -jnp.inf)
    m = jnp.max(scores, axis=-1, keepdims=True)
    p = jnp.exp(scores - m)
    l = jnp.sum(p, axis=-1, keepdims=True)
    o = jnp.einsum('bhrnqk,bhrnkd->bhrnqd', p, vv.astype(jnp.float32)) / l
    lse = (m + jnp.log(l))[..., 0]

    def from_blocks(t):
        tail = t.shape[5:]
        t = t.reshape((b, h, dilation, nb * ATT_BLOCK) + tail)[:, :, :, :sub_len]
        t = jnp.moveaxis(t, 2, 3)
        return t.reshape((b, h, s) + tail)

    return from_blocks(o), from_blocks(lse)


def dilated_mixture_attention(q, k, v, q_gain, k_gain, pos):
    q = partial_rope(rms_norm(q, q_gain), pos)
    k = partial_rope(rms_norm(k, k_gain), pos)
    outs, lses = [], []
    for window, dilation in DILATED_PATTERNS:
        o, lse = dilated_window_attention(q, k, v, window, dilation)
        outs.append(o)
        lses.append(lse)
    alpha = jax.nn.softmax(jnp.stack(lses, axis=0), axis=0)
    o = jnp.einsum('pbhs,pbhsd->bhsd', alpha, jnp.stack(outs, axis=0))
    return o.astype(v.dtype)


def route(h_flat, router_w, router_bias):
    t = h_flat.shape[0]
    scores = jax.nn.sigmoid(jnp.dot(h_flat.astype(jnp.float32), router_w.astype(jnp.float32)))
    sel = scores + router_bias.astype(jnp.float32)
    grp = sel.reshape(t, N_GROUPS, N_EXPERTS // N_GROUPS)
    grp_score = jnp.sum(lax.top_k(grp, 2)[0], axis=-1)
    _, gidx = lax.top_k(grp_score, TOPK_GROUPS)
    gmask = jnp.sum(jax.nn.one_hot(gidx, N_GROUPS, dtype=jnp.float32), axis=1)
    emask = jnp.repeat(gmask, N_EXPERTS // N_GROUPS, axis=1) > 0
    _, idx = lax.top_k(jnp.where(emask, sel, -jnp.inf), TOP_K)
    w = jnp.take_along_axis(scores, idx, axis=1)
    w = w / jnp.sum(w, axis=-1, keepdims=True) * ROUTED_SCALE
    return idx, w


def routed_experts(h_flat, idx, w, w_gate, w_up, w_down):
    t, d = h_flat.shape
    m = t * TOP_K
    flat_e = idx.reshape(m).astype(jnp.int32)
    flat_tok = jnp.repeat(jnp.arange(t, dtype=jnp.int32), TOP_K)
    flat_w = w.reshape(m)
    order = jnp.argsort(flat_e)
    sorted_e, sorted_tok, sorted_w = flat_e[order], flat_tok[order], flat_w[order]
    counts = jnp.bincount(flat_e, length=N_EXPERTS).astype(jnp.int32)
    padded = (counts + MOE_BLOCK - 1) // MOE_BLOCK * MOE_BLOCK
    padded_end = jnp.cumsum(padded)
    padded_start = padded_end - padded
    group_start = jnp.cumsum(counts) - counts
    dest = padded_start[sorted_e] + jnp.arange(m, dtype=jnp.int32) - group_start[sorted_e]
    n_blocks = -(-m // MOE_BLOCK) + N_EXPERTS
    buf = n_blocks * MOE_BLOCK
    tok_buf = jnp.full((buf,), t, jnp.int32).at[dest].set(sorted_tok)
    w_buf = jnp.zeros((buf,), h_flat.dtype).at[dest].set(sorted_w.astype(h_flat.dtype))
    block_e = jnp.minimum(
        jnp.searchsorted(padded_end, jnp.arange(n_blocks, dtype=jnp.int32) * MOE_BLOCK, side='right'),
        N_EXPERTS - 1)
    h_ext = jnp.concatenate([h_flat, jnp.zeros((1, d), h_flat.dtype)], axis=0)

    def step(acc, blk):
        tok, gw, e = blk
        xb = h_ext[tok]
        hid = jax.nn.silu(xb @ w_gate[e]) * (xb @ w_up[e])
        y = (hid @ w_down[e]) * gw[:, None]
        return acc.at[tok].add(y), None

    acc0 = jnp.zeros((t + 1, d), h_flat.dtype)
    acc, _ = lax.scan(step, acc0, (tok_buf.reshape(n_blocks, MOE_BLOCK),
                                   w_buf.reshape(n_blocks, MOE_BLOCK), block_e))
    return acc[:t]


def setup_inputs(seed: int = 0) -> dict:
    key = jax.random.key(seed)
    ks = jax.random.split(key, 24)
    f32 = jnp.float32

    def nrm(k, shape, scale):
        return jax.random.normal(k, shape, f32) * scale

    def gain(k, shape):
        return 1.0 + 0.05 * jax.random.normal(k, shape, f32)

    L, D, E = DEPTH, D_MODEL, N_EXPERTS
    return {
        'x': nrm(ks[0], (BATCH, SEQ, D), 1.0),
        'c': nrm(ks[1], (BATCH, D), 1.0),
        'ada_w': nrm(ks[2], (L, D, N_MOD * D), 0.5 * D ** -0.5),
        'ada_b': nrm(ks[3], (L, N_MOD * D), 0.01),
        'mix_norm': gain(ks[4], (L, D)),
        'w_in': nrm(ks[5], (L, D, D_IN), D ** -0.5),
        'sgu_norm': gain(ks[6], (L, SGU_WIDTH)),
        'sgu_w': nrm(ks[7], (L, SGU_GROUPS, SGU_CHUNK, SGU_CHUNK), SGU_CHUNK ** -0.5),
        'sgu_b': gain(ks[8], (L, SGU_GROUPS, SGU_CHUNK)),
        'q_norm': gain(ks[9], (L, HEAD_DIM)),
        'k_norm': gain(ks[10], (L, HEAD_DIM)),
        'out_norm_sgu': gain(ks[11], (L, SGU_WIDTH)),
        'out_norm_att': gain(ks[12], (L, ATT_WIDTH)),
        'w_out': nrm(ks[13], (L, D_MIX, D), D_MIX ** -0.5),
        'ffn_norm': gain(ks[14], (L, D)),
        'router_w': nrm(ks[15], (L, D, E), D ** -0.5),
        'router_bias': nrm(ks[16], (L, E), 0.01),
        'exp_gate': nrm(ks[17], (L, E, D, EXPERT_DIM), D ** -0.5),
        'exp_up': nrm(ks[18], (L, E, D, EXPERT_DIM), D ** -0.5),
        'exp_down': nrm(ks[19], (L, E, EXPERT_DIM, D), EXPERT_DIM ** -0.5),
        'shared_gate': nrm(ks[20], (L, D, SHARED_DIM), D ** -0.5),
        'shared_up': nrm(ks[21], (L, D, SHARED_DIM), D ** -0.5),
        'shared_down': nrm(ks[22], (L, SHARED_DIM, D), SHARED_DIM ** -0.5),
    }


def reference(x, c, ada_w, ada_b, mix_norm, w_in, sgu_norm, sgu_w, sgu_b, q_norm, k_norm,
              out_norm_sgu, out_norm_att, w_out, ffn_norm, router_w, router_bias,
              exp_gate, exp_up, exp_down, shared_gate, shared_up, shared_down):
    b, s, d = x.shape
    pos = jnp.arange(s, dtype=jnp.int32)
    cond = jax.nn.silu(c)
    splits = [2 * SGU_WIDTH, 2 * SGU_WIDTH + ATT_WIDTH, 2 * SGU_WIDTH + 2 * ATT_WIDTH]
    for l in range(DEPTH):
        mod = (cond @ ada_w[l] + ada_b[l])[:, None, :]
        sh_m, sc_m, g_m, sh_f, sc_f, g_f = jnp.split(mod, N_MOD, axis=-1)

        h = rms_norm(x, mix_norm[l]) * (1 + sc_m) + sh_m
        proj = h @ w_in[l]
        uv, q, k, v = jnp.split(proj, splits, axis=-1)
        y_sgu = chunked_spatial_gating(uv, sgu_norm[l], sgu_w[l], sgu_b[l])
        y_sgu = rms_norm(y_sgu.reshape(b, s, SGU_GROUPS, HEAD_DIM),
                         out_norm_sgu[l].reshape(SGU_GROUPS, HEAD_DIM)).reshape(b, s, SGU_WIDTH)

        def heads(t):
            return t.reshape(b, s, ATT_HEADS, HEAD_DIM).transpose(0, 2, 1, 3)

        y_att = dilated_mixture_attention(heads(q), heads(k), heads(v), q_norm[l], k_norm[l], pos)
        y_att = rms_norm(y_att.transpose(0, 2, 1, 3),
                         out_norm_att[l].reshape(ATT_HEADS, HEAD_DIM)).reshape(b, s, ATT_WIDTH)
        mixed = jnp.concatenate([y_sgu, y_att], axis=-1) @ w_out[l]
        x = x + g_m * mixed

        h = rms_norm(x, ffn_norm[l]) * (1 + sc_f) + sh_f
        h_flat = h.reshape(b * s, d)
        idx, gw = route(h_flat, router_w[l], router_bias[l])
        y_routed = routed_experts(h_flat, idx, gw, exp_gate[l], exp_up[l], exp_down[l])
        y_shared = (jax.nn.silu(h_flat @ shared_gate[l]) * (h_flat @ shared_up[l])) @ shared_down[l]
        x = x + g_f * (y_routed + y_shared).reshape(b, s, d)
    return x
```

```cpp
#include <hip/hip_runtime.h>
#include <cstdio>
#include <cstdint>
#include <cmath>

#ifndef N_LAUNCH_MODE
#define N_LAUNCH_MODE 0
#endif

#define LAS __attribute__((address_space(3)))
typedef unsigned short bf16_t;
typedef short bf16x8 __attribute__((ext_vector_type(8)));
typedef short s16x4 __attribute__((ext_vector_type(4)));
typedef float f32x4 __attribute__((ext_vector_type(4)));
typedef float f32x2 __attribute__((ext_vector_type(2)));
typedef unsigned u32x4 __attribute__((ext_vector_type(4)));
typedef unsigned u32x2 __attribute__((ext_vector_type(2)));

constexpr int SEQ = 16384, DM = 2048, DIN = 5120, NEXP = 64, NEXS = 65, NLAYER = 2;
constexpr float NEPS = 1e-6f;
constexpr int NWAVES = 8, NTHREADS = 512;
constexpr int HID_ROWS = 131072 + 64 * 256 + 16384;

constexpr size_t MiB = 1u << 20;
constexpr size_t WS_CTL = 0, CTL_BYTES = 1 * MiB;
constexpr int CW_BAR = 4096;
constexpr int CW_CNT = 8192;
constexpr int CW_MOD = 32768;
constexpr size_t WS_ROPE = 1 * MiB;
constexpr size_t WS_SGUW = 3 * MiB;
constexpr size_t WS_RT = 4 * MiB;
constexpr size_t WS_TOKLIST = 5 * MiB;
constexpr size_t WS_TOKSEL = 9 * MiB;
constexpr size_t WS_GW = 9 * MiB + 512 * 1024;
constexpr size_t WS_LSE = 10 * MiB;
constexpr size_t WS_MODP = 11 * MiB + 512 * 1024;
constexpr size_t WS_W = 16 * MiB;
constexpr size_t W_IN = 0, W_OUT = 20 * MiB, W_GU = 28 * MiB, W_D = W_GU + 65 * 4 * MiB, W_LAYER = W_D + 65 * 2 * MiB;
constexpr size_t WS_H = WS_W + 2 * W_LAYER;
constexpr size_t WS_HID = WS_H + 64 * MiB;
constexpr size_t WS_Y = WS_HID + (size_t)HID_ROWS * 1024;
constexpr size_t WS_PROJ = WS_Y;
constexpr size_t WS_YMIX = WS_PROJ + 160 * MiB;
constexpr size_t WS_ATT = WS_YMIX + 64 * MiB;
constexpr size_t WS_END = WS_Y + (size_t)HID_ROWS * 4096;
static_assert(WS_ATT + 96 * MiB <= WS_END, "overlay");

constexpr int LDS_BYTES = 147456;
constexpr int LDS_TAB = 131072;
constexpr int LDS_TOK = 132096;
constexpr int LDS_MISC = 147200;

__device__ __forceinline__ unsigned cvt_pk_bf16(float lo, float hi) { unsigned r; asm volatile("v_cvt_pk_bf16_f32 %0, %1, %2" : "=v"(r) : "v"(lo), "v"(hi)); return r; }
__device__ __forceinline__ float bf_lo(unsigned w) { return __uint_as_float(w << 16); }
__device__ __forceinline__ float bf_hi(unsigned w) { return __uint_as_float(w & 0xffff0000u); }
__device__ __forceinline__ float bf2f(bf16_t b) { return __uint_as_float(((unsigned)b) << 16); }
__device__ __forceinline__ float wave_sum(float v) {
#pragma unroll
    for (int o = 1; o < 64; o <<= 1) v += __shfl_xor(v, o);
    return v;
}
__device__ __forceinline__ f32x2 gelu_pk(f32x2 v) {
    const f32x2 av = __builtin_elementwise_abs(v), d = av * 0.2316418882f + 1.0f;
    f32x2 t; t.x = __builtin_amdgcn_rcpf(d.x); t.y = __builtin_amdgcn_rcpf(d.y);
    f32x2 q = t * 0.5307027145f + (-0.7265760135f); q = q * t + 0.7107068705f; q = q * t + (-0.142248368f); q = q * t + 0.127414796f; q = q * t;
    const f32x2 s = (v * v) * (-0.72134752044f);
    f32x2 e; e.x = __builtin_amdgcn_exp2f(s.x); e.y = __builtin_amdgcn_exp2f(s.y);
    const f32x2 m = v * (q * e), r = v - m;
    f32x2 o; o.x = v.x < 0.f ? m.x : r.x; o.y = v.y < 0.f ? m.y : r.y; return o;
}
__device__ __forceinline__ float gelu1(float x) { f32x2 v = {x, 0.f}; return gelu_pk(v).x; }
__device__ __forceinline__ float silu1(float x) { return x * __builtin_amdgcn_rcpf(1.0f + __expf(-x)); }
__device__ __forceinline__ s16x4 lds_tr(const LAS unsigned char* p) { return __builtin_bit_cast(s16x4, __builtin_amdgcn_ds_read_tr16_b64_v4i16((LAS s16x4*)p)); }
__device__ __forceinline__ bf16x8 cat4(s16x4 a, s16x4 b) { bf16x8 r; r[0] = a[0]; r[1] = a[1]; r[2] = a[2]; r[3] = a[3]; r[4] = b[0]; r[5] = b[1]; r[6] = b[2]; r[7] = b[3]; return r; }
__device__ __forceinline__ void unpack8(const u32x4 w, float (&f)[8]) { f[0] = bf_lo(w.x); f[1] = bf_hi(w.x); f[2] = bf_lo(w.y); f[3] = bf_hi(w.y); f[4] = bf_lo(w.z); f[5] = bf_hi(w.z); f[6] = bf_lo(w.w); f[7] = bf_hi(w.w); }
__device__ __forceinline__ u32x4 pack8(const float (&f)[8]) { u32x4 w; w.x = cvt_pk_bf16(f[0], f[1]); w.y = cvt_pk_bf16(f[2], f[3]); w.z = cvt_pk_bf16(f[4], f[5]); w.w = cvt_pk_bf16(f[6], f[7]); return w; }

#define XB_TMO      128
#define XB_XCNT(j)  (256  + 64 * (j))
#define XB_XSUB(j)  (1280 + 64 * (j))
#define XB_XGEN(j)  (2304 + 64 * (j))
#define XB_TOP      3328
#define XB_TOPGEN   3392
#define XCD_BAR_WORDS 3456
#define XB_SPIN_CAP (1u << 18)
__device__ __forceinline__ unsigned xb_ld(unsigned* p)              { return __hip_atomic_load(p, __ATOMIC_RELAXED, __HIP_MEMORY_SCOPE_AGENT); }
__device__ __forceinline__ unsigned xb_add(unsigned* p, unsigned v) { return __hip_atomic_fetch_add(p, v, __ATOMIC_RELAXED, __HIP_MEMORY_SCOPE_AGENT); }
__device__ __forceinline__ unsigned xb_xcc_id() { return (unsigned)__builtin_amdgcn_s_getreg((3 << 11) | 20) & 0xFu; }
#define XB_SPIN(cond, bar) do { unsigned _sp = 0; while (cond) { __builtin_amdgcn_s_sleep(1); \
    if ((++_sp & 255u) == 0u) { if (xb_ld(&(bar)[XB_TMO])) break; if (_sp > XB_SPIN_CAP) { atomicAdd(&(bar)[XB_TMO], 1u); break; } } } } while (0)
struct XcdBarrier { unsigned* bar; unsigned x; volatile LAS unsigned* st; };
__device__ __forceinline__ XcdBarrier xcd_barrier_post(unsigned* bar, volatile LAS unsigned* st) {
    XcdBarrier b; b.bar = bar; b.x = xb_xcc_id(); b.st = st;
    if (threadIdx.x == 0) (void)xb_add(&bar[XB_XCNT(b.x)], 1u);
    return b;
}
__device__ __forceinline__ void xcd_barrier_complete(unsigned* bar, unsigned x, unsigned& nloc, unsigned& nx) {
    const unsigned G = gridDim.x * gridDim.y * gridDim.z;
    unsigned sum, cnt, mine, sp = 0u;
    for (;;) {
        sum = 0u; cnt = 0u; mine = 0u;
#pragma unroll
        for (unsigned j = 0; j < 16; ++j) { const unsigned c = xb_ld(&bar[XB_XCNT(j)]); sum += c; cnt += (c > 0u) ? 1u : 0u; mine = (j == x) ? c : mine; }
        if (sum == G) break;
        __builtin_amdgcn_s_sleep(1);
        if ((++sp & 255u) == 0u) { if (xb_ld(&bar[XB_TMO])) break; if (sp > XB_SPIN_CAP) { atomicAdd(&bar[XB_TMO], 1u); break; } }
    }
    nloc = mine > 0u ? mine : 1u; nx = cnt > 0u ? cnt : 1u;
}
__device__ __forceinline__ void xcd_barrier(const XcdBarrier& b) {
    asm volatile("s_waitcnt vmcnt(0)" ::: "memory");
    __syncthreads();
    if (threadIdx.x == 0) {
        unsigned* bar = b.bar;
        __builtin_amdgcn_s_waitcnt(0);
        unsigned nloc = b.st[0], nx = b.st[1];
        if (nloc == 0u) { xcd_barrier_complete(bar, b.x, nloc, nx); b.st[0] = nloc; b.st[1] = nx; }
        const unsigned old = xb_add(&bar[XB_XSUB(b.x)], 1u);
        const unsigned gen = old / nloc;
        if (old + 1u == (gen + 1u) * nloc) {
            __builtin_amdgcn_fence(__ATOMIC_RELEASE, "agent");
            asm volatile("s_waitcnt vmcnt(0)" ::: "memory");
            const unsigned og = xb_add(&bar[XB_TOP], 1u);
            const unsigned tg = og / nx;
            if (og + 1u == (tg + 1u) * nx) xb_add(&bar[XB_TOPGEN], 1u);
            else XB_SPIN(xb_ld(&bar[XB_TOPGEN]) == tg, bar);
            __builtin_amdgcn_fence(__ATOMIC_ACQUIRE, "agent");
            xb_add(&bar[XB_XGEN(b.x)], 1u);
            asm volatile("s_waitcnt vmcnt(0)" ::: "memory");
        } else {
            XB_SPIN(xb_ld(&bar[XB_XGEN(b.x)]) == gen, bar);
            __builtin_amdgcn_fence(__ATOMIC_ACQUIRE, "agent");
            asm volatile("s_waitcnt vmcnt(0)" ::: "memory");
        }
    }
    __syncthreads();
}

namespace pg8 {
constexpr int BM = 256, BK = 64, HALF = 128, HTB = HALF * BK * 2, STAGE_BYTES = 8 * HTB, NXCD = 8, WGM = 8;
__host__ __device__ __forceinline__ int lds_byte(int r, int c) { const int st = (r >> 4) * 2 + (c >> 5), rr = r & 15, cc = c & 31, ob = rr * 64 + cc * 2; return st * 1024 + (ob ^ (((ob >> 9) & 1) << 5)); }
__host__ __device__ __forceinline__ void stage_rc(int b, int& R, int& C) { const int st = b / 1024, sb = b % 1024, swz = sb ^ (((sb >> 9) & 1) << 5); R = (st >> 1) * 16 + swz / 64; C = (st & 1) * 32 + (swz % 64) / 2; }
__host__ __device__ __forceinline__ int perm32(int rho) { const int n = rho >> 4, i = rho & 15; return 8 * (i >> 2) + 4 * n + (i & 3); }

struct Unit { int pm, pn, e, ord; };

struct DenseSched {
    static constexpr bool GATHER = false;
    const char* A; const char* Bt; int K, nM, nN, nwg, G, c;
    __device__ void init(const void* A_, const void* Bt_, int M, int N, int K_, int G_, int c_) { A = (const char*)A_; Bt = (const char*)Bt_; K = K_; nM = M / BM; nN = N / BM; nwg = nM * nN; G = G_; c = c_; }
    __device__ __forceinline__ bool next(int i, Unit& u) const {
        const long L = (long)i * G + c; if (L >= nwg) return false;
        int wgid = (int)L; { const int q = nwg / NXCD, r = nwg % NXCD, xcd = wgid % NXCD, off = wgid / NXCD; wgid = (xcd < r ? xcd * (q + 1) : r * (q + 1) + (xcd - r) * q) + off; }
        const int nig = WGM * nN, gid = wgid / nig, fm = gid * WGM, gsz = (nM - fm) < WGM ? (nM - fm) : WGM;
        u.pm = fm + ((wgid % nig) % gsz); u.pn = (wgid % nig) / gsz; u.e = 0; u.ord = i; return true;
    }
    __device__ __forceinline__ void locate(const Unit& u, const char*& a, const char*& b) const { a = A + (size_t)u.pm * BM * K * 2; b = Bt + (size_t)u.pn * BM * K * 2; }
    __device__ __forceinline__ unsigned arow(const Unit&, int row) const { return (unsigned)(row * K) * 2u; }
};
template <int KK, int NTN, bool GATHER_>
struct GroupSched {
    static constexpr bool GATHER = GATHER_;
    const char* A; const char* Bt; const LAS int* seg; const LAS int* tpre; const LAS int* toks;
    int G, c;
    static constexpr size_t bstride = (size_t)NTN * BM * KK * 2;
    __device__ __forceinline__ bool next(int i, Unit& u) const {
        const int L = i * G + c; const int mtg = L / NTN; const int total = tpre[65];
        if (mtg >= total) return false;
        int lo = 0, hi = 65;
        while (hi - lo > 1) { const int mid = (lo + hi) >> 1; if (tpre[mid] <= mtg) lo = mid; else hi = mid; }
        lo = __builtin_amdgcn_readfirstlane(lo);
        u.e = lo; u.pm = __builtin_amdgcn_readfirstlane(mtg - tpre[lo]); u.pn = L % NTN; u.ord = i; return true;
    }
    __device__ __forceinline__ void locate(const Unit& u, const char*& a, const char*& b) const {
        b = Bt + (size_t)u.e * bstride + (size_t)u.pn * BM * KK * 2;
        a = GATHER ? A : A + (size_t)(seg[u.e] + u.pm * BM) * KK * 2;
    }
    __device__ __forceinline__ unsigned arow(const Unit& u, int row) const { return (unsigned)toks[u.ord * 256 + row] * (unsigned)(KK * 2); }
};

template <class Epi, class Sched>
__device__ __forceinline__ void gemm_phase(LAS unsigned char* lds, const int K, const Sched& S, const Epi& E, const int tid) {
    const int wid = __builtin_amdgcn_readfirstlane(tid >> 6), lane = tid & 63, wr = wid >> 2, wc = wid & 3, fr = lane & 15, fq = lane >> 4;
    const int nt = K / BK;
    constexpr bool GATHER = Sched::GATHER;
    unsigned voffB[2];
#pragma unroll
    for (int i = 0; i < 2; ++i) { int R, C; stage_rc(tid * 16 + i * 8192, R, C); const int Rb = Epi::PERM ? ((R & ~31) + perm32(R & 31)) : R;
        voffB[i] = (unsigned)(Rb * K + C) * 2u; }
    const size_t kstep = (size_t)(BK * 2);
    const size_t hstepB = (size_t)HALF * K * 2;
#define PG8_SETVA(u) do { _Pragma("unroll") for (int _h = 0; _h < (GATHER ? 2 : 1); ++_h) _Pragma("unroll") for (int _i = 0; _i < 2; ++_i) { int _R, _C; stage_rc(tid * 16 + _i * 8192, _R, _C); \
        vaC[_h][_i] = (GATHER ? S.arow(u, _h * HALF + _R) : (unsigned)(_R * K) * 2u) + (unsigned)_C * 2u; } } while (0)
    const unsigned ldsw = (unsigned)wid * 1024u;
    const int aoff = lds_byte(wr * 64 + fr, fq * 8), boff = lds_byte(wc * 32 + fr, fq * 8);
#define PG8_SA(b, h) (((b) * 2 + (h)) * HTB)
#define PG8_SB(b, h) ((4 + (b) * 2 + (h)) * HTB)
#define PG8_STAGE_B(bufoff, gbase) do { _Pragma("unroll") for (int _i = 0; _i < 2; ++_i) \
        __builtin_amdgcn_global_load_lds((const unsigned*)((const char*)(gbase) + voffB[_i]), (LAS unsigned*)(lds + (bufoff) + ldsw + _i * 8192), 16, 0, 0); } while (0)
#define PG8_STAGE_A(bufoff, gbase, h) do { _Pragma("unroll") for (int _i = 0; _i < 2; ++_i) \
        __builtin_amdgcn_global_load_lds((const unsigned*)((const char*)(gbase) + (GATHER ? (size_t)0 : (size_t)(h) * hstepB) + vaC[GATHER ? (h) : 0][_i]), (LAS unsigned*)(lds + (bufoff) + ldsw + _i * 8192), 16, 0, 0); } while (0)
#define PG8_LDA(dst, b, h) do { _Pragma("unroll") for (int m = 0; m < 4; ++m) _Pragma("unroll") for (int k = 0; k < 2; ++k) dst[m][k] = *(const LAS bf16x8*)(lds + PG8_SA(b, h) + aoff + m * 2048 + k * 1024); } while (0)
#define PG8_LDB(dst, b, h) do { _Pragma("unroll") for (int n = 0; n < 2; ++n) _Pragma("unroll") for (int k = 0; k < 2; ++k) dst[n][k] = *(const LAS bf16x8*)(lds + PG8_SB(b, h) + boff + n * 2048 + k * 1024); } while (0)
#define PG8_MMA(ai, bj, At, Bt) do { __builtin_amdgcn_s_setprio(1); _Pragma("unroll") for (int m = 0; m < 4; ++m) _Pragma("unroll") for (int n = 0; n < 2; ++n) _Pragma("unroll") for (int k = 0; k < 2; ++k) \
        acc[ai][bj][m][n] = __builtin_amdgcn_mfma_f32_16x16x32_bf16(Bt[n][k], At[m][k], acc[ai][bj][m][n], 0, 0, 0); __builtin_amdgcn_s_setprio(0); } while (0)
#define PG8_WAIT_V(n) asm volatile("s_waitcnt vmcnt(" #n ")" ::: "memory")
#define PG8_WAIT_L(n) asm volatile("s_waitcnt lgkmcnt(" #n ")" ::: "memory")
#define PG8_BAR __builtin_amdgcn_s_barrier()
#define PG8_SCHED __builtin_amdgcn_sched_barrier(0)
    Unit cur, nxt; int ui = 0;
    if (!S.next(0, cur)) return;
    f32x4 acc[2][2][4][2];
#pragma unroll
    for (int a = 0; a < 2; ++a)
#pragma unroll
        for (int b = 0; b < 2; ++b)
#pragma unroll
            for (int m = 0; m < 4; ++m)
#pragma unroll
                for (int n = 0; n < 2; ++n) acc[a][b][m][n] = (f32x4){0.f, 0.f, 0.f, 0.f};
    bf16x8 At[4][2], B0[2][2], B1[2][2];
    const char* cA; const char* cB; S.locate(cur, cA, cB);
    unsigned vaC[2][2];
    PG8_SETVA(cur);
    PG8_STAGE_B(PG8_SB(0, 0), cB); PG8_STAGE_B(PG8_SB(0, 1), cB + hstepB); PG8_STAGE_A(PG8_SA(0, 0), cA, 0); PG8_STAGE_A(PG8_SA(0, 1), cA, 1);
    if (wr == 1) PG8_BAR;
    PG8_WAIT_V(2); PG8_BAR;
    PG8_STAGE_B(PG8_SB(1, 0), cB + kstep); PG8_STAGE_A(PG8_SA(1, 0), cA + kstep, 0); PG8_STAGE_B(PG8_SB(1, 1), cB + hstepB + kstep);
    PG8_WAIT_V(6); PG8_BAR;
    for (;;) {
        const bool has_next = S.next(ui + 1, nxt);
        const char* nA = cA; const char* nB = cB;
        if (has_next) S.locate(nxt, nA, nB);
        for (int t = 0; t < nt; t += 2) {
            const bool last = (t == nt - 2);
            const char* a1 = cA + (size_t)(t + 1) * kstep;
            const char* a2 = last ? nA : cA + (size_t)(t + 2) * kstep; const char* b2 = last ? nB : cB + (size_t)(t + 2) * kstep;
            const char* a3 = a2 + kstep; const char* b3 = b2 + kstep;
            PG8_LDB(B0, 0, 0); PG8_LDB(B1, 0, 1); PG8_SCHED; PG8_LDA(At, 0, 0); PG8_STAGE_A(PG8_SA(1, 1), a1, 1);
            if (GATHER && last && has_next) PG8_SETVA(nxt);
            PG8_WAIT_V(8); PG8_WAIT_L(0); PG8_BAR; PG8_MMA(0, 0, At, B0); PG8_MMA(0, 1, At, B1); PG8_BAR; PG8_SCHED;
            PG8_LDA(At, 0, 1); PG8_STAGE_B(PG8_SB(0, 0), b2); PG8_STAGE_B(PG8_SB(0, 1), b2 + hstepB); PG8_STAGE_A(PG8_SA(0, 0), a2, 0);
            PG8_WAIT_V(8); PG8_WAIT_L(0); PG8_BAR; PG8_MMA(1, 0, At, B0); PG8_MMA(1, 1, At, B1); PG8_BAR; PG8_SCHED;
            PG8_LDB(B0, 1, 0); PG8_LDB(B1, 1, 1); PG8_SCHED; PG8_LDA(At, 1, 0); PG8_STAGE_A(PG8_SA(0, 1), a2, 1);
            PG8_WAIT_V(8); PG8_WAIT_L(0); PG8_BAR; PG8_MMA(0, 0, At, B0); PG8_MMA(0, 1, At, B1); PG8_BAR; PG8_SCHED;
            PG8_LDA(At, 1, 1); PG8_STAGE_B(PG8_SB(1, 0), b3); PG8_STAGE_B(PG8_SB(1, 1), b3 + hstepB); PG8_STAGE_A(PG8_SA(1, 0), a3, 0);
            PG8_WAIT_V(8); PG8_WAIT_L(0); PG8_BAR; PG8_MMA(1, 0, At, B0); PG8_MMA(1, 1, At, B1); PG8_BAR; PG8_SCHED;
        }
        if (wr == 0) PG8_BAR;
        E(acc, cur, wr, wc, fr, fq);
        if (!has_next) break;
#pragma unroll
        for (int a = 0; a < 2; ++a)
#pragma unroll
            for (int b = 0; b < 2; ++b)
#pragma unroll
                for (int m = 0; m < 4; ++m)
#pragma unroll
                    for (int n = 0; n < 2; ++n) acc[a][b][m][n] = (f32x4){0.f, 0.f, 0.f, 0.f};
        cur = nxt; cA = nA; cB = nB; ++ui;
        if (wr == 1) PG8_BAR;
    }
    PG8_WAIT_V(0);
    PG8_BAR;
#undef PG8_SA
#undef PG8_SB
#undef PG8_STAGE_A
#undef PG8_SETVA
#undef PG8_STAGE_B
#undef PG8_LDA
#undef PG8_LDB
#undef PG8_MMA
#undef PG8_WAIT_V
#undef PG8_WAIT_L
#undef PG8_BAR
#undef PG8_SCHED
}

struct EpiBf16 {
    static constexpr bool PERM = true;
    bf16_t* O; int ldc; const LAS int* seg; int grouped;
    __device__ __forceinline__ void operator()(const f32x4 (&acc)[2][2][4][2], const Unit& u, int wr, int wc, int fr, int fq) const {
        const int rbase = (grouped ? seg[u.e] : 0) + u.pm * BM + wr * 64 + fr;
        const int col0 = u.pn * BM + wc * 32 + 8 * fq;
#pragma unroll
        for (int ai = 0; ai < 2; ++ai)
#pragma unroll
            for (int m = 0; m < 4; ++m) { bf16_t* rowp = O + (size_t)(rbase + ai * HALF + m * 16) * ldc + col0;
#pragma unroll
                for (int bj = 0; bj < 2; ++bj) { const f32x4 v0 = acc[ai][bj][m][0], v1 = acc[ai][bj][m][1];
                    u32x4 w; w.x = cvt_pk_bf16(v0[0], v0[1]); w.y = cvt_pk_bf16(v0[2], v0[3]); w.z = cvt_pk_bf16(v1[0], v1[1]); w.w = cvt_pk_bf16(v1[2], v1[3]);
                    *(u32x4*)(rowp + bj * HALF) = w; } }
    }
};
struct EpiGateUp {
    static constexpr bool PERM = true;
    bf16_t* O; const LAS int* seg;
    __device__ __forceinline__ void operator()(const f32x4 (&acc)[2][2][4][2], const Unit& u, int wr, int wc, int fr, int fq) const {
        const int rbase = seg[u.e] + u.pm * BM + wr * 64 + fr;
        const int col0 = u.pn * HALF + wc * 32 + 8 * fq;
#pragma unroll
        for (int ai = 0; ai < 2; ++ai)
#pragma unroll
            for (int m = 0; m < 4; ++m) { bf16_t* rowp = O + (size_t)(rbase + ai * HALF + m * 16) * 512 + col0;
                float h[8];
#pragma unroll
                for (int n = 0; n < 2; ++n)
#pragma unroll
                    for (int j = 0; j < 4; ++j) h[4 * n + j] = silu1(acc[ai][0][m][n][j]) * acc[ai][1][m][n][j];
                *(u32x4*)rowp = pack8(h); }
    }
};
struct EpiResid {
    static constexpr bool PERM = false;
    const float* xin; float* out; const float* g;
    __device__ __forceinline__ void operator()(const f32x4 (&acc)[2][2][4][2], const Unit& u, int wr, int wc, int fr, int fq) const {
        const int row0 = u.pm * BM + wr * 64 + fr, col0 = u.pn * BM + wc * 32 + 4 * fq;
        f32x4 gv[2][2];
#pragma unroll
        for (int bj = 0; bj < 2; ++bj)
#pragma unroll
            for (int n = 0; n < 2; ++n) gv[bj][n] = *(const f32x4*)(g + col0 + bj * HALF + n * 16);
#pragma unroll
        for (int ai = 0; ai < 2; ++ai)
#pragma unroll
            for (int m = 0; m < 4; ++m) { const size_t off = (size_t)(row0 + ai * HALF + m * 16) * DM + col0;
#pragma unroll
                for (int bj = 0; bj < 2; ++bj)
#pragma unroll
                    for (int n = 0; n < 2; ++n) { const f32x4 xv = *(const f32x4*)(xin + off + bj * HALF + n * 16);
                        *(f32x4*)(out + off + bj * HALF + n * 16) = xv + gv[bj][n] * acc[ai][bj][m][n]; } }
    }
};
}

struct Args { const float* in[23]; float* out; unsigned char* ws; int ph_lo, ph_hi; };
enum { I_X = 0, I_C, I_ADAW, I_ADAB, I_MIXN, I_WIN, I_SGUN, I_SGUW, I_SGUB, I_QN, I_KN, I_ONS, I_ONA, I_WOUT, I_FFNN, I_RW, I_RB, I_EG, I_EU, I_ED, I_SG, I_SU, I_SD };

__device__ __forceinline__ void transpose_item(const float* W, int K, int N, bf16_t* WT, int kb, int nb, int dst_row0, LAS float* scr, int lane) {
    const int k0 = 64 * kb, n0 = 32 * nb;
#pragma unroll 8
    for (int i = 0; i < 32; ++i) { const int kk = 2 * i + (lane >> 5); scr[kk * 33 + (lane & 31)] = W[(size_t)(k0 + kk) * N + n0 + (lane & 31)]; }
    asm volatile("s_waitcnt lgkmcnt(0)" ::: "memory");
    const int c = lane & 7;
#pragma unroll
    for (int j = 0; j < 4; ++j) { const int n = (lane >> 3) + 8 * j; const LAS float* s = scr + (8 * c) * 33 + n;
        u32x4 o; o.x = cvt_pk_bf16(s[0 * 33], s[1 * 33]); o.y = cvt_pk_bf16(s[2 * 33], s[3 * 33]); o.z = cvt_pk_bf16(s[4 * 33], s[5 * 33]); o.w = cvt_pk_bf16(s[6 * 33], s[7 * 33]);
        *(u32x4*)(WT + (size_t)(dst_row0 + n) * K + k0 + 8 * c) = o; }
    asm volatile("s_waitcnt lgkmcnt(0)" ::: "memory");
}

__device__ __forceinline__ void phase_prologue(const Args& a, LAS unsigned char* lds, int tid, int wave, int lane) {
    const int G = gridDim.x, gw = blockIdx.x * NWAVES + wave, NGW = G * NWAVES;
    const size_t gt = (size_t)blockIdx.x * NTHREADS + tid, NGT = (size_t)G * NTHREADS;
    unsigned char* ws = a.ws;
    {
        float* modp = (float*)(ws + WS_MODP);
        for (int u = gw; u < 2 * 16 * 48; u += NGW) {
            const int l = u / 768, r = u % 768, kc = r / 48, cc = r % 48;
            const float* w = a.in[I_ADAW] + ((size_t)l * DM + kc * 128) * 12288 + cc * 256 + 4 * lane;
            const float* cv = a.in[I_C] + kc * 128;
            f32x4 s = {0.f, 0.f, 0.f, 0.f};
#pragma unroll 8
            for (int k = 0; k < 128; ++k) { const float cvk = cv[k]; const float cd = cvk / (1.0f + __expf(-cvk)); const f32x4 wv = *(const f32x4*)(w + (size_t)k * 12288); s += wv * cd; }
            *(f32x4*)(modp + ((size_t)kc * 2 + l) * 12288 + cc * 256 + 4 * lane) = s;
        }
    }
    {
        float* rope = (float*)(ws + WS_ROPE);
        for (size_t i = gt; i < (size_t)SEQ * 16; i += NGT) {
            const int pos = (int)(i >> 4), f = (int)(i & 15);
            const float inv = (float)exp2(-(double)f * (1.0 / 16.0) * 18.931568569324174);
            const float ang = (float)pos * inv;
            double rev = (double)ang * 0.15915494309189535; rev -= rint(rev);
            rope[2 * i] = __builtin_amdgcn_cosf((float)rev); rope[2 * i + 1] = __builtin_amdgcn_sinf((float)rev);
        }
    }
    {
        bf16_t* sg = (bf16_t*)(ws + WS_SGUW);
        for (size_t i = gt; i < (size_t)2 * 8 * 128 * 128; i += NGT) { const int jj = (int)(i & 127), ii = (int)((i >> 7) & 127); const float v = a.in[I_SGUW][i];
            sg[i] = (bf16_t)(cvt_pk_bf16(jj <= ii ? v : 0.f, 0.f) & 0xffffu); }
        bf16_t* rt = (bf16_t*)(ws + WS_RT);
        for (size_t i = gt; i < (size_t)2 * 2048 * 64; i += NGT) { const int l = (int)(i >> 17), r = (int)(i & 131071), k = r >> 6, e = r & 63; const float v = a.in[I_RW][i];
            const unsigned hi = cvt_pk_bf16(v, 0.f) & 0xffffu; const float lo = v - __uint_as_float(hi << 16);
            rt[(size_t)l * 262144 + e * 2048 + k] = (bf16_t)hi; rt[(size_t)l * 262144 + 131072 + e * 2048 + k] = (bf16_t)(cvt_pk_bf16(lo, 0.f) & 0xffffu); }
    }
    {
        LAS float* scr = (LAS float*)(lds + wave * 16384);
        constexpr int PER_LAYER = 5120 + 2048 + 65 * 1536;
        for (int it = gw; it < 2 * PER_LAYER; it += NGW) {
            const int l = it / PER_LAYER; int r = it % PER_LAYER;
            unsigned char* wl = ws + WS_W + (size_t)l * W_LAYER;
            if (r < 5120) { transpose_item(a.in[I_WIN] + (size_t)l * DM * DIN, DM, DIN, (bf16_t*)(wl + W_IN), r / 160, r % 160, 32 * (r % 160), scr, lane); continue; }
            r -= 5120;
            if (r < 2048) { transpose_item(a.in[I_WOUT] + (size_t)l * DM * DM, DM, DM, (bf16_t*)(wl + W_OUT), r / 64, r % 64, 32 * (r % 64), scr, lane); continue; }
            r -= 2048;
            const int e = r / 1536, q = r % 1536, which = q / 512, s = q % 512;
            if (which < 2) {
                const float* src = (e < 64) ? a.in[which == 0 ? I_EG : I_EU] + ((size_t)l * 64 + e) * (size_t)DM * 512 : a.in[which == 0 ? I_SG : I_SU] + (size_t)l * DM * 512;
                const int kb = s / 16, nb = s % 16, n0 = 32 * nb;
                transpose_item(src, DM, 512, (bf16_t*)(wl + W_GU + (size_t)e * 4 * MiB), kb, nb, 256 * (n0 >> 7) + 128 * which + (n0 & 127), scr, lane);
            } else {
                const float* src = (e < 64) ? a.in[I_ED] + ((size_t)l * 64 + e) * (size_t)512 * DM : a.in[I_SD] + (size_t)l * 512 * DM;
                const int kb = s / 64, nb = s % 64;
                transpose_item(src, 512, DM, (bf16_t*)(wl + W_D + (size_t)e * 2 * MiB), kb, nb, 32 * nb, scr, lane);
            }
        }
    }
}

__device__ __forceinline__ void phase_modreduce(const Args& a, int tid) {
    const float* modp = (const float*)(a.ws + WS_MODP); float* mod = (float*)(a.ws + WS_CTL) + CW_MOD;
    for (int i = blockIdx.x * NTHREADS + tid; i < 2 * 12288; i += gridDim.x * NTHREADS) { float s = a.in[I_ADAB][i];
#pragma unroll
        for (int kc = 0; kc < 16; ++kc) s += modp[(size_t)kc * 24576 + i];
        mod[i] = s; }
}

__device__ __forceinline__ void load_row(const float* row, int lane, f32x4 (&v)[8]) {
#pragma unroll
    for (int j = 0; j < 4; ++j) { const f32x4* p = (const f32x4*)(row + 8 * (64 * j + lane)); v[2 * j] = p[0]; v[2 * j + 1] = p[1]; }
}
__device__ __forceinline__ float sumsq8(const f32x4 (&v)[8]) { float s = 0.f;
#pragma unroll
    for (int j = 0; j < 8; ++j) s += (v[j][0] * v[j][0] + v[j][1] * v[j][1]) + (v[j][2] * v[j][2] + v[j][3] * v[j][3]);
    return s; }
__device__ __forceinline__ void load_mod_vecs(const float* gain, const float* sc, const float* sh, int lane, f32x4 (&ga)[8], f32x4 (&gb)[8]) {
    f32x4 g[8], s[8]; load_row(gain, lane, g); load_row(sc, lane, s); load_row(sh, lane, gb);
#pragma unroll
    for (int j = 0; j < 8; ++j) ga[j] = g[j] * (s[j] + 1.0f);
}
__device__ __forceinline__ void store_row_bf16(bf16_t* row, int lane, const f32x4 (&h)[8]) {
#pragma unroll
    for (int j = 0; j < 4; ++j) { u32x4 w; w.x = cvt_pk_bf16(h[2 * j][0], h[2 * j][1]); w.y = cvt_pk_bf16(h[2 * j][2], h[2 * j][3]); w.z = cvt_pk_bf16(h[2 * j + 1][0], h[2 * j + 1][1]); w.w = cvt_pk_bf16(h[2 * j + 1][2], h[2 * j + 1][3]);
        *(u32x4*)(row + 8 * (64 * j + lane)) = w; }
}

__device__ __forceinline__ void phase_norm1(const Args& a, int l, const float* xin, int wave, int lane) {
    const int gw = blockIdx.x * NWAVES + wave, NGW = gridDim.x * NWAVES;
    const float* mod = (const float*)(a.ws + WS_CTL) + CW_MOD + l * 12288;
    bf16_t* H = (bf16_t*)(a.ws + WS_H);
    f32x4 ga[8], gb[8]; load_mod_vecs(a.in[I_MIXN] + l * DM, mod + 2048, mod + 0, lane, ga, gb);
    for (int m = gw; m < SEQ; m += NGW) {
        f32x4 v[8]; load_row(xin + (size_t)m * DM, lane, v);
        const float rstd = rsqrtf(wave_sum(sumsq8(v)) * (1.0f / DM) + NEPS);
#pragma unroll
        for (int j = 0; j < 8; ++j) v[j] = v[j] * rstd * ga[j] + gb[j];
        store_row_bf16(H + (size_t)m * DM, lane, v);
    }
}

__device__ __forceinline__ void phase_post(const Args& a, int l, int wave, int lane) {
    const int gw = blockIdx.x * NWAVES + wave, NGW = gridDim.x * NWAVES;
    bf16_t* P = (bf16_t*)(a.ws + WS_PROJ);
    const float* rope = (const float*)(a.ws + WS_ROPE);
    const int c0 = 16 * lane;
    const int dim0 = (lane & 7) * 16;
    float gs[16], gq[16], gk[16];
#pragma unroll
    for (int j = 0; j < 16; ++j) { gs[j] = a.in[I_SGUN][l * 1024 + c0 + j]; gq[j] = a.in[I_QN][l * 128 + dim0 + j]; gk[j] = a.in[I_KN][l * 128 + dim0 + j]; }
    for (int m = gw; m < SEQ; m += NGW) {
        bf16_t* row = P + (size_t)m * DIN;
        { u32x4 w0 = *(const u32x4*)(row + c0), w1 = *(const u32x4*)(row + c0 + 8); float f[16]; { float t[8]; unpack8(w0, t);
#pragma unroll
              for (int j = 0; j < 8; ++j) f[j] = t[j]; unpack8(w1, t);
#pragma unroll
              for (int j = 0; j < 8; ++j) f[8 + j] = t[j]; }
#pragma unroll
          for (int j = 0; j < 16; ++j) f[j] = gelu1(f[j]);
          float t0[8], t1[8];
#pragma unroll
          for (int j = 0; j < 8; ++j) { t0[j] = f[j]; t1[j] = f[8 + j]; }
          *(u32x4*)(row + c0) = pack8(t0); *(u32x4*)(row + c0 + 8) = pack8(t1); }
        { u32x4 w0 = *(const u32x4*)(row + 1024 + c0), w1 = *(const u32x4*)(row + 1024 + c0 + 8); float f[16]; { float t[8]; unpack8(w0, t);
#pragma unroll
              for (int j = 0; j < 8; ++j) f[j] = t[j]; unpack8(w1, t);
#pragma unroll
              for (int j = 0; j < 8; ++j) f[8 + j] = t[j]; }
          float ss = 0.f;
#pragma unroll
          for (int j = 0; j < 16; ++j) { f[j] = gelu1(f[j]); ss += f[j] * f[j]; }
          ss += __shfl_xor(ss, 1); ss += __shfl_xor(ss, 2); ss += __shfl_xor(ss, 4);
          const float rstd = rsqrtf(ss * (1.0f / 128.0f) + NEPS);
          float t0[8], t1[8];
#pragma unroll
          for (int j = 0; j < 8; ++j) { t0[j] = f[j] * rstd * gs[j]; t1[j] = f[8 + j] * rstd * gs[8 + j]; }
          *(u32x4*)(row + 1024 + c0) = pack8(t0); *(u32x4*)(row + 1024 + c0 + 8) = pack8(t1); }
#pragma unroll
        for (int qk = 0; qk < 2; ++qk) {
            bf16_t* p = row + 2048 + qk * 1024 + c0;
            u32x4 w0 = *(const u32x4*)p, w1 = *(const u32x4*)(p + 8); float f[16]; { float t[8]; unpack8(w0, t);
#pragma unroll
              for (int j = 0; j < 8; ++j) f[j] = t[j]; unpack8(w1, t);
#pragma unroll
              for (int j = 0; j < 8; ++j) f[8 + j] = t[j]; }
            float ss = 0.f;
#pragma unroll
            for (int j = 0; j < 16; ++j) ss += f[j] * f[j];
            ss += __shfl_xor(ss, 1); ss += __shfl_xor(ss, 2); ss += __shfl_xor(ss, 4);
            const float rstd = rsqrtf(ss * (1.0f / 128.0f) + NEPS);
#pragma unroll
            for (int j = 0; j < 16; ++j) f[j] = f[j] * rstd * (qk == 0 ? gq[j] : gk[j]);
            const int sub = lane & 7;
#pragma unroll
            for (int j = 0; j < 16; ++j) { const float other = __shfl_xor(f[j], 1);
                if (sub < 2) { const float cs = rope[((size_t)m * 16 + j) * 2], sn = rope[((size_t)m * 16 + j) * 2 + 1];
                    f[j] = (sub == 0) ? (f[j] * cs - other * sn) : (f[j] * cs + other * sn); } }
            float t0[8], t1[8];
#pragma unroll
            for (int j = 0; j < 8; ++j) { t0[j] = f[j]; t1[j] = f[8 + j]; }
            *(u32x4*)p = pack8(t0); *(u32x4*)(p + 8) = pack8(t1);
        }
    }
}

constexpr int TSTR = 288;
__device__ __forceinline__ void sgu_unit(const Args& a, int l, LAS unsigned char* lds, int uid, int tid, int wid, int lane) {
    const int n = uid >> 3, g = uid & 7;
    const bf16_t* P = (const bf16_t*)(a.ws + WS_PROJ);
    bf16_t* YM = (bf16_t*)(a.ws + WS_YMIX);
    LAS unsigned char* LU = lds; LAS unsigned char* LV = lds + 128 * TSTR;
#pragma unroll
    for (int it = 0; it < 4; ++it) { const int c = tid + 512 * it, row = c >> 4, ch = c & 15;
        const bf16_t* src = P + (size_t)(128 * n + row) * DIN + 128 * g + 8 * ch;
        *(LAS u32x4*)(LU + row * TSTR + ch * 16) = *(const u32x4*)src;
        *(LAS u32x4*)(LV + row * TSTR + ch * 16) = *(const u32x4*)(src + 1024); }
    __syncthreads();
    const int fr = lane & 15, kg = lane >> 4, q4 = fr >> 2, p4 = lane & 3;
    const bf16_t* W = (const bf16_t*)(a.ws + WS_SGUW) + ((size_t)(l * 8 + g) * 128 + 16 * wid + fr) * 128 + 8 * kg;
    bf16x8 af[4];
#pragma unroll
    for (int ks = 0; ks < 4; ++ks) af[ks] = *(const bf16x8*)(W + 32 * ks);
    f32x4 acc[8];
#pragma unroll
    for (int ct = 0; ct < 8; ++ct) { acc[ct] = (f32x4){0.f, 0.f, 0.f, 0.f};
#pragma unroll
        for (int ks = 0; ks < 4; ++ks) { const LAS unsigned char* vb = LV + (32 * ks + 8 * kg + q4) * TSTR + (16 * ct + 4 * p4) * 2;
            const bf16x8 bfr = cat4(lds_tr(vb), lds_tr(vb + 4 * TSTR));
            acc[ct] = __builtin_amdgcn_mfma_f32_16x16x32_bf16(af[ks], bfr, acc[ct], 0, 0, 0); } }
    float bsv[4], ss[4] = {0.f, 0.f, 0.f, 0.f};
#pragma unroll
    for (int r = 0; r < 4; ++r) bsv[r] = a.in[I_SGUB][(l * 8 + g) * 128 + 16 * wid + 4 * kg + r];
#pragma unroll
    for (int ct = 0; ct < 8; ++ct)
#pragma unroll
        for (int r = 0; r < 4; ++r) { const int i = 16 * wid + 4 * kg + r, c = 16 * ct + fr;
            const float u = bf2f(*(const LAS bf16_t*)(LU + i * TSTR + c * 2));
            const float y = u * (acc[ct][r] + bsv[r]); acc[ct][r] = y; ss[r] += y * y; }
#pragma unroll
    for (int r = 0; r < 4; ++r) { float s = ss[r]; s += __shfl_xor(s, 1); s += __shfl_xor(s, 2); s += __shfl_xor(s, 4); s += __shfl_xor(s, 8); ss[r] = rsqrtf(s * (1.0f / 128.0f) + NEPS); }
#pragma unroll
    for (int ct = 0; ct < 8; ++ct) { const int c = 16 * ct + fr; const float go = a.in[I_ONS][l * 1024 + 128 * g + c];
#pragma unroll
        for (int r = 0; r < 4; ++r) { const int i = 16 * wid + 4 * kg + r;
            YM[(size_t)(128 * n + i) * DM + 128 * g + c] = (bf16_t)(cvt_pk_bf16(acc[ct][r] * ss[r] * go, 0.f) & 0xffffu); } }
    __syncthreads();
}

__device__ __forceinline__ void attn_unit(const Args& a, LAS unsigned char* lds, int uid, int tid, int wid, int lane) {
    const int p = uid >> 10, rem = uid & 1023, h = rem >> 7, rn = rem & 127;
    const int dsh = 2 * p, nbsh = 7 - dsh;
    const int r = rn >> nbsh, n = rn & ((1 << nbsh) - 1);
    const int qbase = r + ((128 * n) << dsh);
    const int kbase = qbase - (128 << dsh);
    const bf16_t* P = (const bf16_t*)(a.ws + WS_PROJ);
    bf16_t* ATT = (bf16_t*)(a.ws + WS_ATT);
    float* LSE = (float*)(a.ws + WS_LSE);
#pragma unroll
    for (int it = 0; it < 8; ++it) { const int c = tid + 512 * it, row = c >> 4, ch = c & 15;
        const int kj = (n == 0 && row < 128) ? row + 128 : row;
        const int pos = kbase + (kj << dsh);
        *(LAS u32x4*)(lds + row * TSTR + ch * 16) = *(const u32x4*)(P + (size_t)pos * DIN + 4096 + h * 128 + 8 * ch); }
    const int fr = lane & 15, kg = lane >> 4, q4 = fr >> 2, p4 = lane & 3;
    const int qi = 16 * wid + fr;
    const bf16_t* qrow = P + (size_t)(qbase + (qi << dsh)) * DIN + 2048 + h * 128 + 8 * kg;
    bf16x8 qf[4];
#pragma unroll
    for (int ks = 0; ks < 4; ++ks) qf[ks] = *(const bf16x8*)(qrow + 32 * ks);
    f32x4 s[10];
#pragma unroll
    for (int i = 0; i < 10; ++i) { const int T = (wid + i) < 15 ? (wid + i) : 15; int kj = 16 * T + fr; kj = (n == 0 && kj < 128) ? kj + 128 : kj;
        const bf16_t* krow = P + (size_t)(kbase + (kj << dsh)) * DIN + 3072 + h * 128 + 8 * kg;
        f32x4 c4 = {0.f, 0.f, 0.f, 0.f};
#pragma unroll
        for (int ks = 0; ks < 4; ++ks) c4 = __builtin_amdgcn_mfma_f32_16x16x32_bf16(*(const bf16x8*)(krow + 32 * ks), qf[ks], c4, 0, 0, 0);
        s[i] = c4; }
    const float sc = 0.08838834764831845f * 1.4426950408889634f;
    float mx = -INFINITY;
#pragma unroll
    for (int i = 0; i < 10; ++i)
#pragma unroll
        for (int rg = 0; rg < 4; ++rg) { const int kj = 16 * (wid + i) + 4 * kg + rg, dist = qi + 128 - kj;
            const bool valid = (wid + i <= 15) && dist >= 0 && dist <= 128 && (n > 0 || kj >= 128);
            const float v = valid ? s[i][rg] * sc : -INFINITY; s[i][rg] = v; mx = fmaxf(mx, v); }
    mx = fmaxf(mx, __shfl_xor(mx, 16)); mx = fmaxf(mx, __shfl_xor(mx, 32));
    float sum = 0.f;
#pragma unroll
    for (int i = 0; i < 10; ++i)
#pragma unroll
        for (int rg = 0; rg < 4; ++rg) { const float e = __builtin_amdgcn_exp2f(s[i][rg] - mx); s[i][rg] = e; sum += e; }
    sum += __shfl_xor(sum, 16); sum += __shfl_xor(sum, 32);
    bf16x8 pf[5];
#pragma unroll
    for (int ks = 0; ks < 5; ++ks) { u32x4 w; w.x = cvt_pk_bf16(s[2 * ks][0], s[2 * ks][1]); w.y = cvt_pk_bf16(s[2 * ks][2], s[2 * ks][3]); w.z = cvt_pk_bf16(s[2 * ks + 1][0], s[2 * ks + 1][1]); w.w = cvt_pk_bf16(s[2 * ks + 1][2], s[2 * ks + 1][3]);
        pf[ks] = __builtin_bit_cast(bf16x8, w); }
    __syncthreads();
    f32x4 o[8];
#pragma unroll
    for (int dt = 0; dt < 8; ++dt) o[dt] = (f32x4){0.f, 0.f, 0.f, 0.f};
#pragma unroll
    for (int ks = 0; ks < 5; ++ks) { const int T0 = (wid + 2 * ks) < 15 ? (wid + 2 * ks) : 15, T1 = (wid + 2 * ks + 1) < 15 ? (wid + 2 * ks + 1) : 15;
        const LAS unsigned char* v0 = lds + (16 * T0 + 4 * kg + q4) * TSTR + 8 * p4;
        const LAS unsigned char* v1 = lds + (16 * T1 + 4 * kg + q4) * TSTR + 8 * p4;
#pragma unroll
        for (int dt = 0; dt < 8; ++dt) { const bf16x8 vf = cat4(lds_tr(v0 + 32 * dt), lds_tr(v1 + 32 * dt));
            o[dt] = __builtin_amdgcn_mfma_f32_16x16x32_bf16(vf, pf[ks], o[dt], 0, 0, 0); } }
    const float inv = 1.0f / sum; const int posq = qbase + (qi << dsh);
    bf16_t* orow = ATT + ((size_t)p * SEQ + posq) * 1024 + h * 128 + 4 * kg;
#pragma unroll
    for (int dt = 0; dt < 8; ++dt) { u32x2 w; w.x = cvt_pk_bf16(o[dt][0] * inv, o[dt][1] * inv); w.y = cvt_pk_bf16(o[dt][2] * inv, o[dt][3] * inv); *(u32x2*)(orow + 16 * dt) = w; }
    if (kg == 0) LSE[((size_t)p * 8 + h) * SEQ + posq] = mx * 0.6931471805599453f + __logf(sum);
    __syncthreads();
}

__device__ __forceinline__ void phase_mix(const Args& a, int l, LAS unsigned char* lds, int tid, int wid, int lane) {
    for (int uid = blockIdx.x; uid < 4096; uid += gridDim.x) {
        if (uid < 1024) sgu_unit(a, l, lds, uid, tid, wid, lane);
        else attn_unit(a, lds, uid - 1024, tid, wid, lane);
    }
}

__device__ __forceinline__ void phase_attcomb(const Args& a, int l, int wave, int lane) {
    const int gw = blockIdx.x * NWAVES + wave, NGW = gridDim.x * NWAVES;
    const bf16_t* ATT = (const bf16_t*)(a.ws + WS_ATT);
    const float* LSE = (const float*)(a.ws + WS_LSE);
    bf16_t* YM = (bf16_t*)(a.ws + WS_YMIX);
    const int h = lane >> 3, c0 = 16 * lane;
    float gn[16];
#pragma unroll
    for (int j = 0; j < 16; ++j) gn[j] = a.in[I_ONA][l * 1024 + c0 + j];
    for (int m = gw; m < SEQ; m += NGW) {
        float ls[3], o[16];
#pragma unroll
        for (int p = 0; p < 3; ++p) ls[p] = LSE[((size_t)p * 8 + h) * SEQ + m];
        const float mxl = fmaxf(ls[0], fmaxf(ls[1], ls[2]));
        float al[3], asum = 0.f;
#pragma unroll
        for (int p = 0; p < 3; ++p) { al[p] = __expf(ls[p] - mxl); asum += al[p]; }
        const float ainv = 1.0f / asum;
#pragma unroll
        for (int j = 0; j < 16; ++j) o[j] = 0.f;
#pragma unroll
        for (int p = 0; p < 3; ++p) { const bf16_t* src = ATT + ((size_t)p * SEQ + m) * 1024 + c0; float t[8]; const float w = al[p] * ainv;
            unpack8(*(const u32x4*)src, t);
#pragma unroll
            for (int j = 0; j < 8; ++j) o[j] += w * t[j];
            unpack8(*(const u32x4*)(src + 8), t);
#pragma unroll
            for (int j = 0; j < 8; ++j) o[8 + j] += w * t[j]; }
        float ss = 0.f;
#pragma unroll
        for (int j = 0; j < 16; ++j) ss += o[j] * o[j];
        ss += __shfl_xor(ss, 1); ss += __shfl_xor(ss, 2); ss += __shfl_xor(ss, 4);
        const float rstd = rsqrtf(ss * (1.0f / 128.0f) + NEPS);
        float t0[8], t1[8];
#pragma unroll
        for (int j = 0; j < 8; ++j) { t0[j] = o[j] * rstd * gn[j]; t1[j] = o[8 + j] * rstd * gn[8 + j]; }
        bf16_t* dst = YM + (size_t)m * DM + 1024 + c0;
        *(u32x4*)dst = pack8(t0); *(u32x4*)(dst + 8) = pack8(t1);
    }
}

constexpr int RSTR = 4112;
__device__ __forceinline__ void phase_router(const Args& a, int l, LAS unsigned char* lds, int tid, int wid, int lane) {
    const float* mod = (const float*)(a.ws + WS_CTL) + CW_MOD + l * 12288;
    const float* x1 = a.out;
    bf16_t* H = (bf16_t*)(a.ws + WS_H);
    LAS unsigned char* HHI = lds; LAS unsigned char* HLO = lds + 16 * RSTR;
    LAS float* LOG = (LAS float*)(lds + 32 * RSTR); LAS float* SEL = LOG + 1024;
    const bf16_t* RTH = (const bf16_t*)(a.ws + WS_RT) + (size_t)l * 262144; const bf16_t* RTL = RTH + 131072;
    unsigned* cnt = (unsigned*)(a.ws + WS_CTL) + CW_CNT + 64 * (l * 64);
    int* toklist = (int*)(a.ws + WS_TOKLIST); int* toksel = (int*)(a.ws + WS_TOKSEL); float* gwt = (float*)(a.ws + WS_GW);
    f32x4 ga[8], gb[8]; load_mod_vecs(a.in[I_FFNN] + l * DM, mod + 4 * 2048, mod + 3 * 2048, lane, ga, gb);
    const int fr = lane & 15, kg = lane >> 4;
    for (int tile = blockIdx.x; tile < SEQ / 16; tile += gridDim.x) {
#pragma unroll
        for (int rr = 0; rr < 2; ++rr) { const int r = 2 * wid + rr, m = 16 * tile + r;
            f32x4 v[8]; load_row(x1 + (size_t)m * DM, lane, v);
            const float rstd = rsqrtf(wave_sum(sumsq8(v)) * (1.0f / DM) + NEPS);
#pragma unroll
            for (int j = 0; j < 8; ++j) v[j] = v[j] * rstd * ga[j] + gb[j];
            store_row_bf16(H + (size_t)m * DM, lane, v);
#pragma unroll
            for (int j = 0; j < 4; ++j) { float f[8] = {v[2 * j][0], v[2 * j][1], v[2 * j][2], v[2 * j][3], v[2 * j + 1][0], v[2 * j + 1][1], v[2 * j + 1][2], v[2 * j + 1][3]};
                const u32x4 hi = pack8(f); float fh[8]; unpack8(hi, fh);
#pragma unroll
                for (int q = 0; q < 8; ++q) f[q] -= fh[q];
                const u32x4 lo = pack8(f);
                *(LAS u32x4*)(HHI + r * RSTR + 16 * (64 * j + lane)) = hi; *(LAS u32x4*)(HLO + r * RSTR + 16 * (64 * j + lane)) = lo; } }
        __syncthreads();
        {
            f32x4 acc[4];
#pragma unroll
            for (int nt = 0; nt < 4; ++nt) acc[nt] = (f32x4){0.f, 0.f, 0.f, 0.f};
#pragma unroll 2
            for (int ks = 0; ks < 8; ++ks) { const int k0 = 256 * wid + 32 * ks + 8 * kg;
                const bf16x8 ah = *(const LAS bf16x8*)(HHI + fr * RSTR + k0 * 2), al = *(const LAS bf16x8*)(HLO + fr * RSTR + k0 * 2);
#pragma unroll
                for (int nt = 0; nt < 4; ++nt) { const bf16x8 bh = *(const bf16x8*)(RTH + (size_t)(16 * nt + fr) * 2048 + k0), bl = *(const bf16x8*)(RTL + (size_t)(16 * nt + fr) * 2048 + k0);
                    acc[nt] = __builtin_amdgcn_mfma_f32_16x16x32_bf16(ah, bh, acc[nt], 0, 0, 0);
                    acc[nt] = __builtin_amdgcn_mfma_f32_16x16x32_bf16(ah, bl, acc[nt], 0, 0, 0);
                    acc[nt] = __builtin_amdgcn_mfma_f32_16x16x32_bf16(al, bh, acc[nt], 0, 0, 0); } }
            __syncthreads();
            LAS float* PART = (LAS float*)lds + wid * 1024;
#pragma unroll
            for (int nt = 0; nt < 4; ++nt)
#pragma unroll
                for (int rg = 0; rg < 4; ++rg) PART[(4 * kg + rg) * 64 + 16 * nt + fr] = acc[nt][rg];
        }
        __syncthreads();
        if (tid < 16) {
            const int tt = tid, m = 16 * tile + tt;
            LAS float* lg = LOG + tt * 64; LAS float* sl = SEL + tt * 64;
            for (int e = 0; e < 64; ++e) { float lgt = 0.f;
#pragma unroll
                for (int w = 0; w < 8; ++w) lgt += ((const LAS float*)lds)[w * 1024 + tt * 64 + e];
                const float s = 1.0f / (1.0f + __expf(-lgt)); lg[e] = s; sl[e] = s + a.in[I_RB][l * 64 + e]; }
            float gsc[8];
#pragma unroll
            for (int g = 0; g < 8; ++g) { float m1 = -INFINITY, m2 = -INFINITY;
                for (int j = 0; j < 8; ++j) { const float v = sl[8 * g + j]; if (v > m1) { m2 = m1; m1 = v; } else if (v > m2) m2 = v; }
                gsc[g] = m1 + m2; }
            unsigned gmask = 0u;
#pragma unroll
            for (int it = 0; it < 4; ++it) { float best = -INFINITY; int bi = 0;
#pragma unroll
                for (int g = 0; g < 8; ++g) { const bool free = !((gmask >> g) & 1u); if (free && gsc[g] > best) { best = gsc[g]; bi = g; } }
                gmask |= 1u << bi; }
            int idx[8]; float wv[8]; float wsum = 0.f;
#pragma unroll
            for (int k = 0; k < 8; ++k) { float best = -INFINITY; int bi = 0;
                for (int e = 0; e < 64; ++e) { const float v = sl[e]; if (((gmask >> (e >> 3)) & 1u) && v > best) { best = v; bi = e; } }
                idx[k] = bi; wv[k] = lg[bi]; wsum += wv[k]; sl[bi] = -INFINITY; }
            const float wn = 2.5f / wsum;
#pragma unroll
            for (int k = 0; k < 8; ++k) { const int e = idx[k]; const unsigned pos = atomicAdd(cnt + 64 * e, 1u);
                toklist[e * SEQ + (int)pos] = m; toksel[m * 8 + k] = e * SEQ + (int)pos; gwt[m * 8 + k] = wv[k] * wn; }
        }
        __syncthreads();
    }
}

__device__ __forceinline__ void build_tables(const Args& a, int l, LAS unsigned char* lds, int tid) {
    LAS int* seg = (LAS int*)(lds + LDS_TAB); LAS int* tpre = (LAS int*)(lds + LDS_TAB + 512);
    if (tid == 0) {
        const unsigned* cnt = (const unsigned*)(a.ws + WS_CTL) + CW_CNT + 64 * (l * 64);
        int s = 0, t = 0;
        for (int e = 0; e < 64; ++e) { const int c = (int)__hip_atomic_load(cnt + 64 * e, __ATOMIC_RELAXED, __HIP_MEMORY_SCOPE_AGENT); const int nt = (c + 255) >> 8; seg[e] = s; tpre[e] = t; s += nt * 256; t += nt; }
        seg[64] = s; tpre[64] = t; tpre[65] = t + 64;
    }
    __syncthreads();
}

__device__ __forceinline__ void phase_combine(const Args& a, int l, int wave, int lane) {
    const int gw = blockIdx.x * NWAVES + wave, NGW = gridDim.x * NWAVES;
    const float* mod = (const float*)(a.ws + WS_CTL) + CW_MOD + l * 12288;
    const bf16_t* Y = (const bf16_t*)(a.ws + WS_Y);
    const int* toksel = (const int*)(a.ws + WS_TOKSEL); const float* gwt = (const float*)(a.ws + WS_GW);
    const unsigned* cnt = (const unsigned*)(a.ws + WS_CTL) + CW_CNT + 64 * (l * 64);
    bf16_t* H = (bf16_t*)(a.ws + WS_H);
    int myc = (((int)__hip_atomic_load(cnt + 64 * lane, __ATOMIC_RELAXED, __HIP_MEMORY_SCOPE_AGENT) + 255) >> 8) << 8, incl = myc;
#pragma unroll
    for (int o = 1; o < 64; o <<= 1) { const int t = __shfl_up(incl, o); if (lane >= o) incl += t; }
    const int segstart = incl - myc; const int segsh = __shfl(incl, 63);
    f32x4 gf[8]; load_row(mod + 5 * 2048, lane, gf);
    f32x4 ga[8], gb[8];
    if (l == 0) { const float* mod1 = mod + 12288; load_mod_vecs(a.in[I_MIXN] + DM, mod1 + 2048, mod1, lane, ga, gb); }
    for (int m = gw; m < SEQ; m += NGW) {
        f32x4 v[8], yacc[8]; load_row(a.out + (size_t)m * DM, lane, v);
#pragma unroll
        for (int j = 0; j < 8; ++j) yacc[j] = (f32x4){0.f, 0.f, 0.f, 0.f};
#pragma unroll
        for (int k = 0; k < 9; ++k) {
            int slot; float w;
            if (k < 8) { const int ts = toksel[m * 8 + k]; const int e = ts >> 14, pos = ts & 16383; slot = __shfl(segstart, e) + pos; w = gwt[m * 8 + k]; }
            else { slot = segsh + m; w = 1.0f; }
            const bf16_t* yr = Y + (size_t)slot * DM;
#pragma unroll
            for (int j = 0; j < 4; ++j) { float t[8]; unpack8(*(const u32x4*)(yr + 8 * (64 * j + lane)), t);
                yacc[2 * j] += (f32x4){t[0], t[1], t[2], t[3]} * w; yacc[2 * j + 1] += (f32x4){t[4], t[5], t[6], t[7]} * w; }
        }
#pragma unroll
        for (int j = 0; j < 8; ++j) v[j] = v[j] + gf[j] * yacc[j];
#pragma unroll
        for (int j = 0; j < 4; ++j) { f32x4* p = (f32x4*)(a.out + (size_t)m * DM + 8 * (64 * j + lane)); p[0] = v[2 * j]; p[1] = v[2 * j + 1]; }
        if (l == 0) {
            const float rstd = rsqrtf(wave_sum(sumsq8(v)) * (1.0f / DM) + NEPS);
#pragma unroll
            for (int j = 0; j < 8; ++j) v[j] = v[j] * rstd * ga[j] + gb[j];
            store_row_bf16(H + (size_t)m * DM, lane, v);
        }
    }
}

constexpr int NPHASE = 22;
__global__ void __launch_bounds__(NTHREADS, 2) trunk_fwd(Args args) {
    extern __shared__ __attribute__((aligned(16))) unsigned char lds_raw[];
    LAS unsigned char* lds = (LAS unsigned char*)lds_raw;
    const int tid = threadIdx.x, lane = tid & 63, wave = __builtin_amdgcn_readfirstlane(tid >> 6);
    volatile LAS unsigned* MISC = (volatile LAS unsigned*)(lds + LDS_MISC);
    if (tid < 64) ((LAS unsigned*)(lds + LDS_MISC))[tid] = 0u;
    __syncthreads();
    unsigned* ctl = (unsigned*)(args.ws + WS_CTL);
    XcdBarrier bar = xcd_barrier_post(ctl + CW_BAR, MISC);
    const int lo = args.ph_lo, hi = args.ph_hi;
#define IN(k) (lo <= (k) && (k) < hi)
#define PBEGIN int ptid = tid; asm volatile("" : "+v"(ptid)); const int plane = ptid & 63; const int pwave = __builtin_amdgcn_readfirstlane(ptid >> 6); (void)plane; (void)pwave;
#define SEAM(k) do { if (IN(k) && IN((k) + 1)) xcd_barrier(bar); } while (0)
    bf16_t* H = (bf16_t*)(args.ws + WS_H);
    bf16_t* PROJ = (bf16_t*)(args.ws + WS_PROJ);
    bf16_t* YMIX = (bf16_t*)(args.ws + WS_YMIX);
    bf16_t* HID = (bf16_t*)(args.ws + WS_HID);
    bf16_t* Y = (bf16_t*)(args.ws + WS_Y);
    const int G = gridDim.x;

    if (IN(0)) { PBEGIN phase_prologue(args, lds, ptid, pwave, plane); }
    SEAM(0);
    if (IN(1)) { PBEGIN phase_modreduce(args, ptid); }
    SEAM(1);
    for (int l = 0; l < NLAYER; ++l) {
        const int pb = 2 + 10 * l;
        unsigned char* wl = args.ws + WS_W + (size_t)l * W_LAYER;
        const float* mod = (const float*)(args.ws + WS_CTL) + CW_MOD + l * 12288;
        if (IN(pb + 0)) { PBEGIN if (l == 0) phase_norm1(args, 0, args.in[I_X], pwave, plane); }
        if (l == 0) SEAM(pb + 0);
        if (IN(pb + 1)) { PBEGIN pg8::DenseSched S; S.init(H, wl + W_IN, SEQ, DIN, DM, G, (int)blockIdx.x); pg8::EpiBf16 E{PROJ, DIN, (const LAS int*)(lds + LDS_TAB), 0};
            pg8::gemm_phase<pg8::EpiBf16, pg8::DenseSched>(lds, DM, S, E, ptid); }
        SEAM(pb + 1);
        if (IN(pb + 2)) { PBEGIN phase_post(args, l, pwave, plane); }
        SEAM(pb + 2);
        if (IN(pb + 3)) { PBEGIN phase_mix(args, l, lds, ptid, pwave, plane); }
        SEAM(pb + 3);
        if (IN(pb + 4)) { PBEGIN phase_attcomb(args, l, pwave, plane); }
        SEAM(pb + 4);
        if (IN(pb + 5)) { PBEGIN pg8::DenseSched S; S.init(YMIX, wl + W_OUT, SEQ, DM, DM, G, (int)blockIdx.x); pg8::EpiResid E{l == 0 ? args.in[I_X] : args.out, args.out, mod + 2 * 2048};
            pg8::gemm_phase<pg8::EpiResid, pg8::DenseSched>(lds, DM, S, E, ptid); }
        SEAM(pb + 5);
        if (IN(pb + 6)) { PBEGIN phase_router(args, l, lds, ptid, pwave, plane); }
        SEAM(pb + 6);
        if (IN(pb + 7)) {
            PBEGIN
            build_tables(args, l, lds, ptid);
            const LAS int* seg = (const LAS int*)(lds + LDS_TAB); const LAS int* tpre = (const LAS int*)(lds + LDS_TAB + 512); LAS int* toks = (LAS int*)(lds + LDS_TOK);
            typedef pg8::GroupSched<DM, 4, true> SchedGU; SchedGU S; S.A = (const char*)H; S.Bt = (const char*)(wl + W_GU); S.seg = seg; S.tpre = tpre; S.toks = toks; S.G = G; S.c = (int)blockIdx.x;
            const unsigned* cnt = (const unsigned*)(args.ws + WS_CTL) + CW_CNT + 64 * (l * 64); const int* toklist = (const int*)(args.ws + WS_TOKLIST);
            { pg8::Unit u;
#pragma unroll 1
              for (int i = 0; i < 14 && S.next(i, u); ++i) { const int c = (u.e < 64) ? (int)__hip_atomic_load(cnt + 64 * u.e, __ATOMIC_RELAXED, __HIP_MEMORY_SCOPE_AGENT) : SEQ;
                  for (int r = ptid; r < 256; r += NTHREADS) { const int rr = u.pm * 256 + r; toks[i * 256 + r] = (rr < c) ? ((u.e < 64) ? toklist[u.e * SEQ + rr] : rr) : 0; } } }
            __syncthreads();
            pg8::EpiGateUp E{HID, seg};
            pg8::gemm_phase<pg8::EpiGateUp, SchedGU>(lds, DM, S, E, ptid);
        }
        SEAM(pb + 7);
        if (IN(pb + 8)) {
            PBEGIN
            build_tables(args, l, lds, ptid);
            const LAS int* seg = (const LAS int*)(lds + LDS_TAB); const LAS int* tpre = (const LAS int*)(lds + LDS_TAB + 512);
            typedef pg8::GroupSched<512, 8, false> SchedD; SchedD S; S.A = (const char*)HID; S.Bt = (const char*)(wl + W_D); S.seg = seg; S.tpre = tpre; S.toks = tpre; S.G = G; S.c = (int)blockIdx.x;
            pg8::EpiBf16 E{Y, DM, seg, 1};
            pg8::gemm_phase<pg8::EpiBf16, SchedD>(lds, 512, S, E, ptid);
        }
        SEAM(pb + 8);
        if (IN(pb + 9)) { PBEGIN phase_combine(args, l, pwave, plane); }
        if (l == 0) SEAM(pb + 9);
    }
#undef IN
#undef SEAM
}

extern "C" void kernel_launch(void* const* d_in, const int* in_sizes, int n_in, void* d_out, int out_size, void* d_ws, size_t ws_size, hipStream_t stream) {
    static int grid = 0;
    if (grid == 0) {
        if (n_in != 23 || out_size != SEQ * DM || ws_size < WS_END) { fprintf(stderr, "kernel_launch: unexpected shapes (n_in %d, out %d, ws %zu < %zu)\n", n_in, out_size, ws_size, (size_t)WS_END); grid = -1; return; }
        int dev = 0, cus = 0, per_cu = 0;
        if (hipGetDevice(&dev) != hipSuccess || hipDeviceGetAttribute(&cus, hipDeviceAttributeMultiprocessorCount, dev) != hipSuccess) { grid = -1; return; }
        if (hipFuncSetAttribute((const void*)trunk_fwd, hipFuncAttributeMaxDynamicSharedMemorySize, LDS_BYTES) != hipSuccess) { fprintf(stderr, "kernel_launch: hipFuncSetAttribute failed\n"); grid = -1; return; }
        if (hipOccupancyMaxActiveBlocksPerMultiprocessor(&per_cu, (const void*)trunk_fwd, NTHREADS, LDS_BYTES) != hipSuccess || per_cu < 1) { fprintf(stderr, "kernel_launch: occupancy query says %d\n", per_cu); }
        (void)hipGetLastError();
        grid = cus;
    }
    if (grid < 0) return;
    (void)hipMemsetAsync((char*)d_ws + WS_CTL, 0, CTL_BYTES, stream);
    Args a{};
    for (int i = 0; i < 23; ++i) a.in[i] = (const float*)d_in[i];
    a.out = (float*)d_out; a.ws = (unsigned char*)d_ws;
#if N_LAUNCH_MODE == 1
    a.ph_lo = 0; a.ph_hi = NPHASE;
    hipLaunchKernelGGL(trunk_fwd, dim3(grid), dim3(NTHREADS), LDS_BYTES, stream, a);
#else
    for (int ph = 0; ph < NPHASE; ++ph) {
        if (ph == 12) continue;
        a.ph_lo = ph; a.ph_hi = ph + 1;
        hipLaunchKernelGGL(trunk_fwd, dim3(grid), dim3(NTHREADS), LDS_BYTES, stream, a);
    }
#endif
}
```

```cpp
#include <hip/hip_runtime.h>
#include <cstdio>
#include <cstdint>
#include <cmath>

#ifndef N_LAUNCH_MODE
#define N_LAUNCH_MODE 1
#endif

#define LAS __attribute__((address_space(3)))
typedef unsigned short bf16_t;
typedef short bf16x8 __attribute__((ext_vector_type(8)));
typedef short s16x4 __attribute__((ext_vector_type(4)));
typedef float f32x4 __attribute__((ext_vector_type(4)));
typedef float f32x2 __attribute__((ext_vector_type(2)));
typedef unsigned u32x4 __attribute__((ext_vector_type(4)));
typedef unsigned u32x2 __attribute__((ext_vector_type(2)));

constexpr int SEQ = 16384, DM = 2048, DIN = 5120, NEXP = 64, NEXS = 65, NLAYER = 2;
constexpr float NEPS = 1e-6f;
constexpr int NWAVES = 8, NTHREADS = 512;
constexpr int HID_ROWS = 131072 + 64 * 256 + 16384;

constexpr size_t MiB = 1u << 20;
constexpr size_t WS_CTL = 0, CTL_BYTES = 1 * MiB;
constexpr int CW_BAR = 4096;
constexpr int CW_CNT = 8192;
constexpr int CW_MOD = 32768;
constexpr size_t WS_ROPE = 1 * MiB;
constexpr size_t WS_SGUW = 3 * MiB;
constexpr size_t WS_RT = 4 * MiB;
constexpr size_t WS_TOKLIST = 5 * MiB;
constexpr size_t WS_TOKSEL = 9 * MiB;
constexpr size_t WS_GW = 9 * MiB + 512 * 1024;
constexpr size_t WS_LSE = 10 * MiB;
constexpr size_t WS_MODP = 11 * MiB + 512 * 1024;
constexpr size_t WS_W = 16 * MiB;
constexpr size_t W_IN = 0, W_OUT = 20 * MiB, W_GU = 28 * MiB, W_D = W_GU + 65 * 4 * MiB, W_LAYER = W_D + 65 * 2 * MiB;
constexpr size_t WS_H = WS_W + 2 * W_LAYER;
constexpr size_t WS_HID = WS_H + 64 * MiB;
constexpr size_t WS_Y = WS_HID + (size_t)HID_ROWS * 1024;
constexpr size_t WS_PROJ = WS_Y;
constexpr size_t WS_YMIX = WS_PROJ + 160 * MiB;
constexpr size_t WS_ATT = WS_YMIX + 64 * MiB;
constexpr size_t WS_END = WS_Y + (size_t)HID_ROWS * 4096;
static_assert(WS_ATT + 96 * MiB <= WS_END, "overlay");

constexpr int LDS_BYTES = 147456;
constexpr int LDS_TAB = 131072;
constexpr int LDS_TOK = 132096;
constexpr int LDS_MISC = 147200;

__device__ __forceinline__ unsigned cvt_pk_bf16(float lo, float hi) { unsigned r; asm volatile("v_cvt_pk_bf16_f32 %0, %1, %2" : "=v"(r) : "v"(lo), "v"(hi)); return r; }
__device__ __forceinline__ float bf_lo(unsigned w) { return __uint_as_float(w << 16); }
__device__ __forceinline__ float bf_hi(unsigned w) { return __uint_as_float(w & 0xffff0000u); }
__device__ __forceinline__ float bf2f(bf16_t b) { return __uint_as_float(((unsigned)b) << 16); }
__device__ __forceinline__ float wave_sum(float v) {
#pragma unroll
    for (int o = 1; o < 64; o <<= 1) v += __shfl_xor(v, o);
    return v;
}
__device__ __forceinline__ f32x2 gelu_pk(f32x2 v) {
    const f32x2 av = __builtin_elementwise_abs(v), d = av * 0.2316418882f + 1.0f;
    f32x2 t; t.x = __builtin_amdgcn_rcpf(d.x); t.y = __builtin_amdgcn_rcpf(d.y);
    f32x2 q = t * 0.5307027145f + (-0.7265760135f); q = q * t + 0.7107068705f; q = q * t + (-0.142248368f); q = q * t + 0.127414796f; q = q * t;
    const f32x2 s = (v * v) * (-0.72134752044f);
    f32x2 e; e.x = __builtin_amdgcn_exp2f(s.x); e.y = __builtin_amdgcn_exp2f(s.y);
    const f32x2 m = v * (q * e), r = v - m;
    f32x2 o; o.x = v.x < 0.f ? m.x : r.x; o.y = v.y < 0.f ? m.y : r.y; return o;
}
__device__ __forceinline__ float gelu1(float x) { f32x2 v = {x, 0.f}; return gelu_pk(v).x; }
__device__ __forceinline__ float silu1(float x) { return x * __builtin_amdgcn_rcpf(1.0f + __expf(-x)); }
__device__ __forceinline__ s16x4 lds_tr(const LAS unsigned char* p) { return __builtin_bit_cast(s16x4, __builtin_amdgcn_ds_read_tr16_b64_v4i16((LAS s16x4*)p)); }
__device__ __forceinline__ bf16x8 cat4(s16x4 a, s16x4 b) { bf16x8 r; r[0] = a[0]; r[1] = a[1]; r[2] = a[2]; r[3] = a[3]; r[4] = b[0]; r[5] = b[1]; r[6] = b[2]; r[7] = b[3]; return r; }
__device__ __forceinline__ void unpack8(const u32x4 w, float (&f)[8]) { f[0] = bf_lo(w.x); f[1] = bf_hi(w.x); f[2] = bf_lo(w.y); f[3] = bf_hi(w.y); f[4] = bf_lo(w.z); f[5] = bf_hi(w.z); f[6] = bf_lo(w.w); f[7] = bf_hi(w.w); }
__device__ __forceinline__ u32x4 pack8(const float (&f)[8]) { u32x4 w; w.x = cvt_pk_bf16(f[0], f[1]); w.y = cvt_pk_bf16(f[2], f[3]); w.z = cvt_pk_bf16(f[4], f[5]); w.w = cvt_pk_bf16(f[6], f[7]); return w; }

#define XB_TMO      128
#define XB_XCNT(j)  (256  + 64 * (j))
#define XB_XSUB(j)  (1280 + 64 * (j))
#define XB_XGEN(j)  (2304 + 64 * (j))
#define XB_TOP      3328
#define XB_TOPGEN   3392
#define XCD_BAR_WORDS 3456
#define XB_SPIN_CAP (1u << 18)
__device__ __forceinline__ unsigned xb_ld(unsigned* p)              { return __hip_atomic_load(p, __ATOMIC_RELAXED, __HIP_MEMORY_SCOPE_AGENT); }
__device__ __forceinline__ unsigned xb_add(unsigned* p, unsigned v) { return __hip_atomic_fetch_add(p, v, __ATOMIC_RELAXED, __HIP_MEMORY_SCOPE_AGENT); }
__device__ __forceinline__ unsigned xb_xcc_id() { return (unsigned)__builtin_amdgcn_s_getreg((3 << 11) | 20) & 0xFu; }
#define XB_SPIN(cond, bar) do { unsigned _sp = 0; while (cond) { __builtin_amdgcn_s_sleep(1); \
    if ((++_sp & 255u) == 0u) { if (xb_ld(&(bar)[XB_TMO])) break; if (_sp > XB_SPIN_CAP) { atomicAdd(&(bar)[XB_TMO], 1u); break; } } } } while (0)
struct XcdBarrier { unsigned* bar; unsigned x; volatile LAS unsigned* st; };
__device__ __forceinline__ XcdBarrier xcd_barrier_post(unsigned* bar, volatile LAS unsigned* st) {
    XcdBarrier b; b.bar = bar; b.x = xb_xcc_id(); b.st = st;
    if (threadIdx.x == 0) (void)xb_add(&bar[XB_XCNT(b.x)], 1u);
    return b;
}
__device__ __forceinline__ void xcd_barrier_complete(unsigned* bar, unsigned x, unsigned& nloc, unsigned& nx) {
    const unsigned G = gridDim.x * gridDim.y * gridDim.z;
    unsigned sum, cnt, mine, sp = 0u;
    for (;;) {
        sum = 0u; cnt = 0u; mine = 0u;
#pragma unroll
        for (unsigned j = 0; j < 16; ++j) { const unsigned c = xb_ld(&bar[XB_XCNT(j)]); sum += c; cnt += (c > 0u) ? 1u : 0u; mine = (j == x) ? c : mine; }
        if (sum == G) break;
        __builtin_amdgcn_s_sleep(1);
        if ((++sp & 255u) == 0u) { if (xb_ld(&bar[XB_TMO])) break; if (sp > XB_SPIN_CAP) { atomicAdd(&bar[XB_TMO], 1u); break; } }
    }
    nloc = mine > 0u ? mine : 1u; nx = cnt > 0u ? cnt : 1u;
}
__device__ __forceinline__ void xcd_barrier(const XcdBarrier& b) {
    asm volatile("s_waitcnt vmcnt(0)" ::: "memory");
    __syncthreads();
    if (threadIdx.x == 0) {
        unsigned* bar = b.bar;
        __builtin_amdgcn_s_waitcnt(0);
        unsigned nloc = b.st[0], nx = b.st[1];
        if (nloc == 0u) { xcd_barrier_complete(bar, b.x, nloc, nx); b.st[0] = nloc; b.st[1] = nx; }
        const unsigned old = xb_add(&bar[XB_XSUB(b.x)], 1u);
        const unsigned gen = old / nloc;
        if (old + 1u == (gen + 1u) * nloc) {
            __builtin_amdgcn_fence(__ATOMIC_RELEASE, "agent");
            asm volatile("s_waitcnt vmcnt(0)" ::: "memory");
            const unsigned og = xb_add(&bar[XB_TOP], 1u);
            const unsigned tg = og / nx;
            if (og + 1u == (tg + 1u) * nx) xb_add(&bar[XB_TOPGEN], 1u);
            else XB_SPIN(xb_ld(&bar[XB_TOPGEN]) == tg, bar);
            __builtin_amdgcn_fence(__ATOMIC_ACQUIRE, "agent");
            xb_add(&bar[XB_XGEN(b.x)], 1u);
            asm volatile("s_waitcnt vmcnt(0)" ::: "memory");
        } else {
            XB_SPIN(xb_ld(&bar[XB_XGEN(b.x)]) == gen, bar);
            __builtin_amdgcn_fence(__ATOMIC_ACQUIRE, "agent");
            asm volatile("s_waitcnt vmcnt(0)" ::: "memory");
        }
    }
    __syncthreads();
}

namespace pg8 {
constexpr int BM = 256, BK = 64, HALF = 128, HTB = HALF * BK * 2, STAGE_BYTES = 8 * HTB, NXCD = 8, WGM = 8;
__host__ __device__ __forceinline__ int lds_byte(int r, int c) { const int st = (r >> 4) * 2 + (c >> 5), rr = r & 15, cc = c & 31, ob = rr * 64 + cc * 2; return st * 1024 + (ob ^ (((ob >> 9) & 1) << 5)); }
__host__ __device__ __forceinline__ void stage_rc(int b, int& R, int& C) { const int st = b / 1024, sb = b % 1024, swz = sb ^ (((sb >> 9) & 1) << 5); R = (st >> 1) * 16 + swz / 64; C = (st & 1) * 32 + (swz % 64) / 2; }
__host__ __device__ __forceinline__ int perm32(int rho) { const int n = rho >> 4, i = rho & 15; return 8 * (i >> 2) + 4 * n + (i & 3); }

struct Unit { int pm, pn, e, ord; };

struct DenseSched {
    static constexpr bool GATHER = false;
    const char* A; const char* Bt; int K, nM, nN, nwg, G, c;
    __device__ void init(const void* A_, const void* Bt_, int M, int N, int K_, int G_, int c_) { A = (const char*)A_; Bt = (const char*)Bt_; K = K_; nM = M / BM; nN = N / BM; nwg = nM * nN; G = G_; c = c_; }
    __device__ __forceinline__ bool next(int i, Unit& u) const {
        const long L = (long)i * G + c; if (L >= nwg) return false;
        int wgid = (int)L; { const int q = nwg / NXCD, r = nwg % NXCD, xcd = wgid % NXCD, off = wgid / NXCD; wgid = (xcd < r ? xcd * (q + 1) : r * (q + 1) + (xcd - r) * q) + off; }
        const int nig = WGM * nN, gid = wgid / nig, fm = gid * WGM, gsz = (nM - fm) < WGM ? (nM - fm) : WGM;
        u.pm = fm + ((wgid % nig) % gsz); u.pn = (wgid % nig) / gsz; u.e = 0; u.ord = i; return true;
    }
    __device__ __forceinline__ void locate(const Unit& u, const char*& a, const char*& b) const { a = A + (size_t)u.pm * BM * K * 2; b = Bt + (size_t)u.pn * BM * K * 2; }
    __device__ __forceinline__ unsigned arow(const Unit&, int row) const { return (unsigned)(row * K) * 2u; }
};
template <int KK, int NTN, bool GATHER_>
struct GroupSched {
    static constexpr bool GATHER = GATHER_;
    const char* A; const char* Bt; const LAS int* seg; const LAS int* tpre; const LAS int* toks;
    int G, c;
    static constexpr size_t bstride = (size_t)NTN * BM * KK * 2;
    __device__ __forceinline__ bool next(int i, Unit& u) const {
        const int L = i * G + c; const int mtg = L / NTN; const int total = tpre[65];
        if (mtg >= total) return false;
        int lo = 0, hi = 65;
        while (hi - lo > 1) { const int mid = (lo + hi) >> 1; if (tpre[mid] <= mtg) lo = mid; else hi = mid; }
        lo = __builtin_amdgcn_readfirstlane(lo);
        u.e = lo; u.pm = __builtin_amdgcn_readfirstlane(mtg - tpre[lo]); u.pn = L % NTN; u.ord = i; return true;
    }
    __device__ __forceinline__ void locate(const Unit& u, const char*& a, const char*& b) const {
        b = Bt + (size_t)u.e * bstride + (size_t)u.pn * BM * KK * 2;
        a = GATHER ? A : A + (size_t)(seg[u.e] + u.pm * BM) * KK * 2;
    }
    __device__ __forceinline__ unsigned arow(const Unit& u, int row) const { return (unsigned)toks[u.ord * 256 + row] * (unsigned)(KK * 2); }
};

template <class Epi, class Sched>
__device__ __forceinline__ void gemm_phase(LAS unsigned char* lds, const int K, const Sched& S, const Epi& E, const int tid) {
    const int wid = __builtin_amdgcn_readfirstlane(tid >> 6), lane = tid & 63, wr = wid >> 2, wc = wid & 3, fr = lane & 15, fq = lane >> 4;
    const int nt = K / BK;
    constexpr bool GATHER = Sched::GATHER;
    unsigned voffB[2];
#pragma unroll
    for (int i = 0; i < 2; ++i) { int R, C; stage_rc(tid * 16 + i * 8192, R, C); const int Rb = Epi::PERM ? ((R & ~31) + perm32(R & 31)) : R;
        voffB[i] = (unsigned)(Rb * K + C) * 2u; }
    const size_t kstep = (size_t)(BK * 2);
    const size_t hstepB = (size_t)HALF * K * 2;
#define PG8_SETVA(u) do { _Pragma("unroll") for (int _h = 0; _h < (GATHER ? 2 : 1); ++_h) _Pragma("unroll") for (int _i = 0; _i < 2; ++_i) { int _R, _C; stage_rc(tid * 16 + _i * 8192, _R, _C); \
        vaC[_h][_i] = (GATHER ? S.arow(u, _h * HALF + _R) : (unsigned)(_R * K) * 2u) + (unsigned)_C * 2u; } } while (0)
    const unsigned ldsw = (unsigned)wid * 1024u;
    const int aoff = lds_byte(wr * 64 + fr, fq * 8), boff = lds_byte(wc * 32 + fr, fq * 8);
#define PG8_SA(b, h) (((b) * 2 + (h)) * HTB)
#define PG8_SB(b, h) ((4 + (b) * 2 + (h)) * HTB)
#define PG8_STAGE_B(bufoff, gbase) do { _Pragma("unroll") for (int _i = 0; _i < 2; ++_i) \
        __builtin_amdgcn_global_load_lds((const unsigned*)((const char*)(gbase) + voffB[_i]), (LAS unsigned*)(lds + (bufoff) + ldsw + _i * 8192), 16, 0, 0); } while (0)
#define PG8_STAGE_A(bufoff, gbase, h) do { _Pragma("unroll") for (int _i = 0; _i < 2; ++_i) \
        __builtin_amdgcn_global_load_lds((const unsigned*)((const char*)(gbase) + (GATHER ? (size_t)0 : (size_t)(h) * hstepB) + vaC[GATHER ? (h) : 0][_i]), (LAS unsigned*)(lds + (bufoff) + ldsw + _i * 8192), 16, 0, 0); } while (0)
#define PG8_LDA(dst, b, h) do { _Pragma("unroll") for (int m = 0; m < 4; ++m) _Pragma("unroll") for (int k = 0; k < 2; ++k) dst[m][k] = *(const LAS bf16x8*)(lds + PG8_SA(b, h) + aoff + m * 2048 + k * 1024); } while (0)
#define PG8_LDB(dst, b, h) do { _Pragma("unroll") for (int n = 0; n < 2; ++n) _Pragma("unroll") for (int k = 0; k < 2; ++k) dst[n][k] = *(const LAS bf16x8*)(lds + PG8_SB(b, h) + boff + n * 2048 + k * 1024); } while (0)
#define PG8_MMA(ai, bj, At, Bt) do { __builtin_amdgcn_s_setprio(1); _Pragma("unroll") for (int m = 0; m < 4; ++m) _Pragma("unroll") for (int n = 0; n < 2; ++n) _Pragma("unroll") for (int k = 0; k < 2; ++k) \
        acc[ai][bj][m][n] = __builtin_amdgcn_mfma_f32_16x16x32_bf16(Bt[n][k], At[m][k], acc[ai][bj][m][n], 0, 0, 0); __builtin_amdgcn_s_setprio(0); } while (0)
#define PG8_WAIT_V(n) asm volatile("s_waitcnt vmcnt(" #n ")" ::: "memory")
#define PG8_WAIT_L(n) asm volatile("s_waitcnt lgkmcnt(" #n ")" ::: "memory")
#define PG8_BAR __builtin_amdgcn_s_barrier()
#define PG8_SCHED __builtin_amdgcn_sched_barrier(0)
    Unit cur, nxt; int ui = 0;
    if (!S.next(0, cur)) return;
    f32x4 acc[2][2][4][2];
#pragma unroll
    for (int a = 0; a < 2; ++a)
#pragma unroll
        for (int b = 0; b < 2; ++b)
#pragma unroll
            for (int m = 0; m < 4; ++m)
#pragma unroll
                for (int n = 0; n < 2; ++n) acc[a][b][m][n] = (f32x4){0.f, 0.f, 0.f, 0.f};
    bf16x8 At[4][2], B0[2][2], B1[2][2];
    const char* cA; const char* cB; S.locate(cur, cA, cB);
    unsigned vaC[2][2];
    PG8_SETVA(cur);
    PG8_STAGE_B(PG8_SB(0, 0), cB); PG8_STAGE_B(PG8_SB(0, 1), cB + hstepB); PG8_STAGE_A(PG8_SA(0, 0), cA, 0); PG8_STAGE_A(PG8_SA(0, 1), cA, 1);
    if (wr == 1) PG8_BAR;
    PG8_WAIT_V(2); PG8_BAR;
    PG8_STAGE_B(PG8_SB(1, 0), cB + kstep); PG8_STAGE_A(PG8_SA(1, 0), cA + kstep, 0); PG8_STAGE_B(PG8_SB(1, 1), cB + hstepB + kstep);
    PG8_WAIT_V(6); PG8_BAR;
    for (;;) {
        const bool has_next = S.next(ui + 1, nxt);
        const char* nA = cA; const char* nB = cB;
        if (has_next) S.locate(nxt, nA, nB);
        for (int t = 0; t < nt; t += 2) {
            const bool last = (t == nt - 2);
            const char* a1 = cA + (size_t)(t + 1) * kstep;
            const char* a2 = last ? nA : cA + (size_t)(t + 2) * kstep; const char* b2 = last ? nB : cB + (size_t)(t + 2) * kstep;
            const char* a3 = a2 + kstep; const char* b3 = b2 + kstep;
            PG8_LDB(B0, 0, 0); PG8_LDB(B1, 0, 1); PG8_SCHED; PG8_LDA(At, 0, 0); PG8_STAGE_A(PG8_SA(1, 1), a1, 1);
            if (GATHER && last && has_next) PG8_SETVA(nxt);
            PG8_WAIT_V(8); PG8_WAIT_L(0); PG8_BAR; PG8_MMA(0, 0, At, B0); PG8_MMA(0, 1, At, B1); PG8_BAR; PG8_SCHED;
            PG8_LDA(At, 0, 1); PG8_STAGE_B(PG8_SB(0, 0), b2); PG8_STAGE_B(PG8_SB(0, 1), b2 + hstepB); PG8_STAGE_A(PG8_SA(0, 0), a2, 0);
            PG8_WAIT_V(8); PG8_WAIT_L(0); PG8_BAR; PG8_MMA(1, 0, At, B0); PG8_MMA(1, 1, At, B1); PG8_BAR; PG8_SCHED;
            PG8_LDB(B0, 1, 0); PG8_LDB(B1, 1, 1); PG8_SCHED; PG8_LDA(At, 1, 0); PG8_STAGE_A(PG8_SA(0, 1), a2, 1);
            PG8_WAIT_V(8); PG8_WAIT_L(0); PG8_BAR; PG8_MMA(0, 0, At, B0); PG8_MMA(0, 1, At, B1); PG8_BAR; PG8_SCHED;
            PG8_LDA(At, 1, 1); PG8_STAGE_B(PG8_SB(1, 0), b3); PG8_STAGE_B(PG8_SB(1, 1), b3 + hstepB); PG8_STAGE_A(PG8_SA(1, 0), a3, 0);
            PG8_WAIT_V(8); PG8_WAIT_L(0); PG8_BAR; PG8_MMA(1, 0, At, B0); PG8_MMA(1, 1, At, B1); PG8_BAR; PG8_SCHED;
        }
        if (wr == 0) PG8_BAR;
        E(acc, cur, wr, wc, fr, fq);
        if (!has_next) break;
#pragma unroll
        for (int a = 0; a < 2; ++a)
#pragma unroll
            for (int b = 0; b < 2; ++b)
#pragma unroll
                for (int m = 0; m < 4; ++m)
#pragma unroll
                    for (int n = 0; n < 2; ++n) acc[a][b][m][n] = (f32x4){0.f, 0.f, 0.f, 0.f};
        cur = nxt; cA = nA; cB = nB; ++ui;
        if (wr == 1) PG8_BAR;
    }
    PG8_WAIT_V(0);
    PG8_BAR;
#undef PG8_SA
#undef PG8_SB
#undef PG8_STAGE_A
#undef PG8_SETVA
#undef PG8_STAGE_B
#undef PG8_LDA
#undef PG8_LDB
#undef PG8_MMA
#undef PG8_WAIT_V
#undef PG8_WAIT_L
#undef PG8_BAR
#undef PG8_SCHED
}

struct EpiBf16 {
    static constexpr bool PERM = true;
    bf16_t* O; int ldc; const LAS int* seg; int grouped;
    __device__ __forceinline__ void operator()(const f32x4 (&acc)[2][2][4][2], const Unit& u, int wr, int wc, int fr, int fq) const {
        const int rbase = (grouped ? seg[u.e] : 0) + u.pm * BM + wr * 64 + fr;
        const int col0 = u.pn * BM + wc * 32 + 8 * fq;
#pragma unroll
        for (int ai = 0; ai < 2; ++ai)
#pragma unroll
            for (int m = 0; m < 4; ++m) { bf16_t* rowp = O + (size_t)(rbase + ai * HALF + m * 16) * ldc + col0;
#pragma unroll
                for (int bj = 0; bj < 2; ++bj) { const f32x4 v0 = acc[ai][bj][m][0], v1 = acc[ai][bj][m][1];
                    u32x4 w; w.x = cvt_pk_bf16(v0[0], v0[1]); w.y = cvt_pk_bf16(v0[2], v0[3]); w.z = cvt_pk_bf16(v1[0], v1[1]); w.w = cvt_pk_bf16(v1[2], v1[3]);
                    *(u32x4*)(rowp + bj * HALF) = w; } }
    }
};
struct EpiGateUp {
    static constexpr bool PERM = true;
    bf16_t* O; const LAS int* seg;
    __device__ __forceinline__ void operator()(const f32x4 (&acc)[2][2][4][2], const Unit& u, int wr, int wc, int fr, int fq) const {
        const int rbase = seg[u.e] + u.pm * BM + wr * 64 + fr;
        const int col0 = u.pn * HALF + wc * 32 + 8 * fq;
#pragma unroll
        for (int ai = 0; ai < 2; ++ai)
#pragma unroll
            for (int m = 0; m < 4; ++m) { bf16_t* rowp = O + (size_t)(rbase + ai * HALF + m * 16) * 512 + col0;
                float h[8];
#pragma unroll
                for (int n = 0; n < 2; ++n)
#pragma unroll
                    for (int j = 0; j < 4; ++j) h[4 * n + j] = silu1(acc[ai][0][m][n][j]) * acc[ai][1][m][n][j];
                *(u32x4*)rowp = pack8(h); }
    }
};
struct EpiResid {
    static constexpr bool PERM = false;
    const float* xin; float* out; const float* g;
    __device__ __forceinline__ void operator()(const f32x4 (&acc)[2][2][4][2], const Unit& u, int wr, int wc, int fr, int fq) const {
        const int row0 = u.pm * BM + wr * 64 + fr, col0 = u.pn * BM + wc * 32 + 4 * fq;
        f32x4 gv[2][2];
#pragma unroll
        for (int bj = 0; bj < 2; ++bj)
#pragma unroll
            for (int n = 0; n < 2; ++n) gv[bj][n] = *(const f32x4*)(g + col0 + bj * HALF + n * 16);
#pragma unroll
        for (int ai = 0; ai < 2; ++ai)
#pragma unroll
            for (int m = 0; m < 4; ++m) { const size_t off = (size_t)(row0 + ai * HALF + m * 16) * DM + col0;
#pragma unroll
                for (int bj = 0; bj < 2; ++bj)
#pragma unroll
                    for (int n = 0; n < 2; ++n) { const f32x4 xv = *(const f32x4*)(xin + off + bj * HALF + n * 16);
                        *(f32x4*)(out + off + bj * HALF + n * 16) = xv + gv[bj][n] * acc[ai][bj][m][n]; } }
    }
};
}

struct Args { const float* in[23]; float* out; unsigned char* ws; int ph_lo, ph_hi; };
enum { I_X = 0, I_C, I_ADAW, I_ADAB, I_MIXN, I_WIN, I_SGUN, I_SGUW, I_SGUB, I_QN, I_KN, I_ONS, I_ONA, I_WOUT, I_FFNN, I_RW, I_RB, I_EG, I_EU, I_ED, I_SG, I_SU, I_SD };

__device__ __forceinline__ void transpose_item(const float* W, int K, int N, bf16_t* WT, int kb, int nb, int dst_row0, LAS float* scr, int lane) {
    const int k0 = 64 * kb, n0 = 32 * nb;
#pragma unroll 8
    for (int i = 0; i < 32; ++i) { const int kk = 2 * i + (lane >> 5); scr[kk * 33 + (lane & 31)] = W[(size_t)(k0 + kk) * N + n0 + (lane & 31)]; }
    asm volatile("s_waitcnt lgkmcnt(0)" ::: "memory");
    const int c = lane & 7;
#pragma unroll
    for (int j = 0; j < 4; ++j) { const int n = (lane >> 3) + 8 * j; const LAS float* s = scr + (8 * c) * 33 + n;
        u32x4 o; o.x = cvt_pk_bf16(s[0 * 33], s[1 * 33]); o.y = cvt_pk_bf16(s[2 * 33], s[3 * 33]); o.z = cvt_pk_bf16(s[4 * 33], s[5 * 33]); o.w = cvt_pk_bf16(s[6 * 33], s[7 * 33]);
        *(u32x4*)(WT + (size_t)(dst_row0 + n) * K + k0 + 8 * c) = o; }
    asm volatile("s_waitcnt lgkmcnt(0)" ::: "memory");
}

__device__ __forceinline__ void phase_prologue(const Args& a, LAS unsigned char* lds, int tid, int wave, int lane) {
    const int G = gridDim.x, gw = blockIdx.x * NWAVES + wave, NGW = G * NWAVES;
    const size_t gt = (size_t)blockIdx.x * NTHREADS + tid, NGT = (size_t)G * NTHREADS;
    unsigned char* ws = a.ws;
    {
        float* modp = (float*)(ws + WS_MODP);
        for (int u = gw; u < 2 * 16 * 48; u += NGW) {
            const int l = u / 768, r = u % 768, kc = r / 48, cc = r % 48;
            const float* w = a.in[I_ADAW] + ((size_t)l * DM + kc * 128) * 12288 + cc * 256 + 4 * lane;
            const float* cv = a.in[I_C] + kc * 128;
            f32x4 s = {0.f, 0.f, 0.f, 0.f};
#pragma unroll 8
            for (int k = 0; k < 128; ++k) { const float cvk = cv[k]; const float cd = cvk / (1.0f + __expf(-cvk)); const f32x4 wv = *(const f32x4*)(w + (size_t)k * 12288); s += wv * cd; }
            *(f32x4*)(modp + ((size_t)kc * 2 + l) * 12288 + cc * 256 + 4 * lane) = s;
        }
    }
    {
        float* rope = (float*)(ws + WS_ROPE);
        for (size_t i = gt; i < (size_t)SEQ * 16; i += NGT) {
            const int pos = (int)(i >> 4), f = (int)(i & 15);
            const float inv = (float)exp2(-(double)f * (1.0 / 16.0) * 18.931568569324174);
            const float ang = (float)pos * inv;
            double rev = (double)ang * 0.15915494309189535; rev -= rint(rev);
            rope[2 * i] = __builtin_amdgcn_cosf((float)rev); rope[2 * i + 1] = __builtin_amdgcn_sinf((float)rev);
        }
    }
    {
        bf16_t* sg = (bf16_t*)(ws + WS_SGUW);
        for (size_t i = gt; i < (size_t)2 * 8 * 128 * 128; i += NGT) { const int jj = (int)(i & 127), ii = (int)((i >> 7) & 127); const float v = a.in[I_SGUW][i];
            sg[i] = (bf16_t)(cvt_pk_bf16(jj <= ii ? v : 0.f, 0.f) & 0xffffu); }
        bf16_t* rt = (bf16_t*)(ws + WS_RT);
        for (size_t i = gt; i < (size_t)2 * 2048 * 64; i += NGT) { const int l = (int)(i >> 17), r = (int)(i & 131071), k = r >> 6, e = r & 63; const float v = a.in[I_RW][i];
            const unsigned hi = cvt_pk_bf16(v, 0.f) & 0xffffu; const float lo = v - __uint_as_float(hi << 16);
            rt[(size_t)l * 262144 + e * 2048 + k] = (bf16_t)hi; rt[(size_t)l * 262144 + 131072 + e * 2048 + k] = (bf16_t)(cvt_pk_bf16(lo, 0.f) & 0xffffu); }
    }
    {
        LAS float* scr = (LAS float*)(lds + wave * 16384);
        constexpr int PER_LAYER = 5120 + 2048 + 65 * 1536;
        for (int it = gw; it < 2 * PER_LAYER; it += NGW) {
            const int l = it / PER_LAYER; int r = it % PER_LAYER;
            unsigned char* wl = ws + WS_W + (size_t)l * W_LAYER;
            if (r < 5120) { transpose_item(a.in[I_WIN] + (size_t)l * DM * DIN, DM, DIN, (bf16_t*)(wl + W_IN), r / 160, r % 160, 32 * (r % 160), scr, lane); continue; }
            r -= 5120;
            if (r < 2048) { transpose_item(a.in[I_WOUT] + (size_t)l * DM * DM, DM, DM, (bf16_t*)(wl + W_OUT), r / 64, r % 64, 32 * (r % 64), scr, lane); continue; }
            r -= 2048;
            const int e = r / 1536, q = r % 1536, which = q / 512, s = q % 512;
            if (which < 2) {
                const float* src = (e < 64) ? a.in[which == 0 ? I_EG : I_EU] + ((size_t)l * 64 + e) * (size_t)DM * 512 : a.in[which == 0 ? I_SG : I_SU] + (size_t)l * DM * 512;
                const int kb = s / 16, nb = s % 16, n0 = 32 * nb;
                transpose_item(src, DM, 512, (bf16_t*)(wl + W_GU + (size_t)e * 4 * MiB), kb, nb, 256 * (n0 >> 7) + 128 * which + (n0 & 127), scr, lane);
            } else {
                const float* src = (e < 64) ? a.in[I_ED] + ((size_t)l * 64 + e) * (size_t)512 * DM : a.in[I_SD] + (size_t)l * 512 * DM;
                const int kb = s / 64, nb = s % 64;
                transpose_item(src, 512, DM, (bf16_t*)(wl + W_D + (size_t)e * 2 * MiB), kb, nb, 32 * nb, scr, lane);
            }
        }
    }
}

__device__ __forceinline__ void phase_modreduce(const Args& a, int tid) {
    const float* modp = (const float*)(a.ws + WS_MODP); float* mod = (float*)(a.ws + WS_CTL) + CW_MOD;
    for (int i = blockIdx.x * NTHREADS + tid; i < 2 * 12288; i += gridDim.x * NTHREADS) { float s = a.in[I_ADAB][i];
#pragma unroll
        for (int kc = 0; kc < 16; ++kc) s += modp[(size_t)kc * 24576 + i];
        mod[i] = s; }
}

__device__ __forceinline__ void load_row(const float* row, int lane, f32x4 (&v)[8]) {
#pragma unroll
    for (int j = 0; j < 4; ++j) { const f32x4* p = (const f32x4*)(row + 8 * (64 * j + lane)); v[2 * j] = p[0]; v[2 * j + 1] = p[1]; }
}
__device__ __forceinline__ float sumsq8(const f32x4 (&v)[8]) { float s = 0.f;
#pragma unroll
    for (int j = 0; j < 8; ++j) s += (v[j][0] * v[j][0] + v[j][1] * v[j][1]) + (v[j][2] * v[j][2] + v[j][3] * v[j][3]);
    return s; }
__device__ __forceinline__ void load_mod_vecs(const float* gain, const float* sc, const float* sh, int lane, f32x4 (&ga)[8], f32x4 (&gb)[8]) {
    f32x4 g[8], s[8]; load_row(gain, lane, g); load_row(sc, lane, s); load_row(sh, lane, gb);
#pragma unroll
    for (int j = 0; j < 8; ++j) ga[j] = g[j] * (s[j] + 1.0f);
}
__device__ __forceinline__ void store_row_bf16(bf16_t* row, int lane, const f32x4 (&h)[8]) {
#pragma unroll
    for (int j = 0; j < 4; ++j) { u32x4 w; w.x = cvt_pk_bf16(h[2 * j][0], h[2 * j][1]); w.y = cvt_pk_bf16(h[2 * j][2], h[2 * j][3]); w.z = cvt_pk_bf16(h[2 * j + 1][0], h[2 * j + 1][1]); w.w = cvt_pk_bf16(h[2 * j + 1][2], h[2 * j + 1][3]);
        *(u32x4*)(row + 8 * (64 * j + lane)) = w; }
}

__device__ __forceinline__ void phase_norm1(const Args& a, int l, const float* xin, int wave, int lane) {
    const int gw = blockIdx.x * NWAVES + wave, NGW = gridDim.x * NWAVES;
    const float* mod = (const float*)(a.ws + WS_CTL) + CW_MOD + l * 12288;
    bf16_t* H = (bf16_t*)(a.ws + WS_H);
    f32x4 ga[8], gb[8]; load_mod_vecs(a.in[I_MIXN] + l * DM, mod + 2048, mod + 0, lane, ga, gb);
    for (int m = gw; m < SEQ; m += NGW) {
        f32x4 v[8]; load_row(xin + (size_t)m * DM, lane, v);
        const float rstd = rsqrtf(wave_sum(sumsq8(v)) * (1.0f / DM) + NEPS);
#pragma unroll
        for (int j = 0; j < 8; ++j) v[j] = v[j] * rstd * ga[j] + gb[j];
        store_row_bf16(H + (size_t)m * DM, lane, v);
    }
}

__device__ __forceinline__ void phase_post(const Args& a, int l, int wave, int lane) {
    const int gw = blockIdx.x * NWAVES + wave, NGW = gridDim.x * NWAVES;
    bf16_t* P = (bf16_t*)(a.ws + WS_PROJ);
    const float* rope = (const float*)(a.ws + WS_ROPE);
    const int c0 = 16 * lane;
    const int dim0 = (lane & 7) * 16;
    float gs[16], gq[16], gk[16];
#pragma unroll
    for (int j = 0; j < 16; ++j) { gs[j] = a.in[I_SGUN][l * 1024 + c0 + j]; gq[j] = a.in[I_QN][l * 128 + dim0 + j]; gk[j] = a.in[I_KN][l * 128 + dim0 + j]; }
    for (int m = gw; m < SEQ; m += NGW) {
        bf16_t* row = P + (size_t)m * DIN;
        { u32x4 w0 = *(const u32x4*)(row + c0), w1 = *(const u32x4*)(row + c0 + 8); float f[16]; { float t[8]; unpack8(w0, t);
#pragma unroll
              for (int j = 0; j < 8; ++j) f[j] = t[j]; unpack8(w1, t);
#pragma unroll
              for (int j = 0; j < 8; ++j) f[8 + j] = t[j]; }
#pragma unroll
          for (int j = 0; j < 16; ++j) f[j] = gelu1(f[j]);
          float t0[8], t1[8];
#pragma unroll
          for (int j = 0; j < 8; ++j) { t0[j] = f[j]; t1[j] = f[8 + j]; }
          *(u32x4*)(row + c0) = pack8(t0); *(u32x4*)(row + c0 + 8) = pack8(t1); }
        { u32x4 w0 = *(const u32x4*)(row + 1024 + c0), w1 = *(const u32x4*)(row + 1024 + c0 + 8); float f[16]; { float t[8]; unpack8(w0, t);
#pragma unroll
              for (int j = 0; j < 8; ++j) f[j] = t[j]; unpack8(w1, t);
#pragma unroll
              for (int j = 0; j < 8; ++j) f[8 + j] = t[j]; }
          float ss = 0.f;
#pragma unroll
          for (int j = 0; j < 16; ++j) { f[j] = gelu1(f[j]); ss += f[j] * f[j]; }
          ss += __shfl_xor(ss, 1); ss += __shfl_xor(ss, 2); ss += __shfl_xor(ss, 4);
          const float rstd = rsqrtf(ss * (1.0f / 128.0f) + NEPS);
          float t0[8], t1[8];
#pragma unroll
          for (int j = 0; j < 8; ++j) { t0[j] = f[j] * rstd * gs[j]; t1[j] = f[8 + j] * rstd * gs[8 + j]; }
          *(u32x4*)(row + 1024 + c0) = pack8(t0); *(u32x4*)(row + 1024 + c0 + 8) = pack8(t1); }
#pragma unroll
        for (int qk = 0; qk < 2; ++qk) {
            bf16_t* p = row + 2048 + qk * 1024 + c0;
            u32x4 w0 = *(const u32x4*)p, w1 = *(const u32x4*)(p + 8); float f[16]; { float t[8]; unpack8(w0, t);
#pragma unroll
              for (int j = 0; j < 8; ++j) f[j] = t[j]; unpack8(w1, t);
#pragma unroll
              for (int j = 0; j < 8; ++j) f[8 + j] = t[j]; }
            float ss = 0.f;
#pragma unroll
            for (int j = 0; j < 16; ++j) ss += f[j] * f[j];
            ss += __shfl_xor(ss, 1); ss += __shfl_xor(ss, 2); ss += __shfl_xor(ss, 4);
            const float rstd = rsqrtf(ss * (1.0f / 128.0f) + NEPS);
#pragma unroll
            for (int j = 0; j < 16; ++j) f[j] = f[j] * rstd * (qk == 0 ? gq[j] : gk[j]);
            const int sub = lane & 7;
#pragma unroll
            for (int j = 0; j < 16; ++j) { const float other = __shfl_xor(f[j], 1);
                if (sub < 2) { const float cs = rope[((size_t)m * 16 + j) * 2], sn = rope[((size_t)m * 16 + j) * 2 + 1];
                    f[j] = (sub == 0) ? (f[j] * cs - other * sn) : (f[j] * cs + other * sn); } }
            float t0[8], t1[8];
#pragma unroll
            for (int j = 0; j < 8; ++j) { t0[j] = f[j]; t1[j] = f[8 + j]; }
            *(u32x4*)p = pack8(t0); *(u32x4*)(p + 8) = pack8(t1);
        }
    }
}

constexpr int TSTR = 288;
__device__ __forceinline__ void sgu_unit(const Args& a, int l, LAS unsigned char* lds, int uid, int tid, int wid, int lane) {
    const int n = uid >> 3, g = uid & 7;
    const bf16_t* P = (const bf16_t*)(a.ws + WS_PROJ);
    bf16_t* YM = (bf16_t*)(a.ws + WS_YMIX);
    LAS unsigned char* LU = lds; LAS unsigned char* LV = lds + 128 * TSTR;
#pragma unroll
    for (int it = 0; it < 4; ++it) { const int c = tid + 512 * it, row = c >> 4, ch = c & 15;
        const bf16_t* src = P + (size_t)(128 * n + row) * DIN + 128 * g + 8 * ch;
        *(LAS u32x4*)(LU + row * TSTR + ch * 16) = *(const u32x4*)src;
        *(LAS u32x4*)(LV + row * TSTR + ch * 16) = *(const u32x4*)(src + 1024); }
    __syncthreads();
    const int fr = lane & 15, kg = lane >> 4, q4 = fr >> 2, p4 = lane & 3;
    const bf16_t* W = (const bf16_t*)(a.ws + WS_SGUW) + ((size_t)(l * 8 + g) * 128 + 16 * wid + fr) * 128 + 8 * kg;
    bf16x8 af[4];
#pragma unroll
    for (int ks = 0; ks < 4; ++ks) af[ks] = *(const bf16x8*)(W + 32 * ks);
    f32x4 acc[8];
#pragma unroll
    for (int ct = 0; ct < 8; ++ct) { acc[ct] = (f32x4){0.f, 0.f, 0.f, 0.f};
#pragma unroll
        for (int ks = 0; ks < 4; ++ks) { const LAS unsigned char* vb = LV + (32 * ks + 8 * kg + q4) * TSTR + (16 * ct + 4 * p4) * 2;
            const bf16x8 bfr = cat4(lds_tr(vb), lds_tr(vb + 4 * TSTR));
            acc[ct] = __builtin_amdgcn_mfma_f32_16x16x32_bf16(af[ks], bfr, acc[ct], 0, 0, 0); } }
    float bsv[4], ss[4] = {0.f, 0.f, 0.f, 0.f};
#pragma unroll
    for (int r = 0; r < 4; ++r) bsv[r] = a.in[I_SGUB][(l * 8 + g) * 128 + 16 * wid + 4 * kg + r];
#pragma unroll
    for (int ct = 0; ct < 8; ++ct)
#pragma unroll
        for (int r = 0; r < 4; ++r) { const int i = 16 * wid + 4 * kg + r, c = 16 * ct + fr;
            const float u = bf2f(*(const LAS bf16_t*)(LU + i * TSTR + c * 2));
            const float y = u * (acc[ct][r] + bsv[r]); acc[ct][r] = y; ss[r] += y * y; }
#pragma unroll
    for (int r = 0; r < 4; ++r) { float s = ss[r]; s += __shfl_xor(s, 1); s += __shfl_xor(s, 2); s += __shfl_xor(s, 4); s += __shfl_xor(s, 8); ss[r] = rsqrtf(s * (1.0f / 128.0f) + NEPS); }
#pragma unroll
    for (int ct = 0; ct < 8; ++ct) { const int c = 16 * ct + fr; const float go = a.in[I_ONS][l * 1024 + 128 * g + c];
#pragma unroll
        for (int r = 0; r < 4; ++r) { const int i = 16 * wid + 4 * kg + r;
            YM[(size_t)(128 * n + i) * DM + 128 * g + c] = (bf16_t)(cvt_pk_bf16(acc[ct][r] * ss[r] * go, 0.f) & 0xffffu); } }
    __syncthreads();
}

__device__ __forceinline__ void attn_unit(const Args& a, LAS unsigned char* lds, int uid, int tid, int wid, int lane) {
    const int p = uid >> 10, rem = uid & 1023, h = rem >> 7, rn = rem & 127;
    const int dsh = 2 * p, nbsh = 7 - dsh;
    const int r = rn >> nbsh, n = rn & ((1 << nbsh) - 1);
    const int qbase = r + ((128 * n) << dsh);
    const int kbase = qbase - (128 << dsh);
    const bf16_t* P = (const bf16_t*)(a.ws + WS_PROJ);
    bf16_t* ATT = (bf16_t*)(a.ws + WS_ATT);
    float* LSE = (float*)(a.ws + WS_LSE);
#pragma unroll
    for (int it = 0; it < 8; ++it) { const int c = tid + 512 * it, row = c >> 4, ch = c & 15;
        const int kj = (n == 0 && row < 128) ? row + 128 : row;
        const int pos = kbase + (kj << dsh);
        *(LAS u32x4*)(lds + row * TSTR + ch * 16) = *(const u32x4*)(P + (size_t)pos * DIN + 4096 + h * 128 + 8 * ch); }
    const int fr = lane & 15, kg = lane >> 4, q4 = fr >> 2, p4 = lane & 3;
    const int qi = 16 * wid + fr;
    const bf16_t* qrow = P + (size_t)(qbase + (qi << dsh)) * DIN + 2048 + h * 128 + 8 * kg;
    bf16x8 qf[4];
#pragma unroll
    for (int ks = 0; ks < 4; ++ks) qf[ks] = *(const bf16x8*)(qrow + 32 * ks);
    f32x4 s[10];
#pragma unroll
    for (int i = 0; i < 10; ++i) { const int T = (wid + i) < 15 ? (wid + i) : 15; int kj = 16 * T + fr; kj = (n == 0 && kj < 128) ? kj + 128 : kj;
        const bf16_t* krow = P + (size_t)(kbase + (kj << dsh)) * DIN + 3072 + h * 128 + 8 * kg;
        f32x4 c4 = {0.f, 0.f, 0.f, 0.f};
#pragma unroll
        for (int ks = 0; ks < 4; ++ks) c4 = __builtin_amdgcn_mfma_f32_16x16x32_bf16(*(const bf16x8*)(krow + 32 * ks), qf[ks], c4, 0, 0, 0);
        s[i] = c4; }
    const float sc = 0.08838834764831845f * 1.4426950408889634f;
    float mx = -INFINITY;
#pragma unroll
    for (int i = 0; i < 10; ++i)
#pragma unroll
        for (int rg = 0; rg < 4; ++rg) { const int kj = 16 * (wid + i) + 4 * kg + rg, dist = qi + 128 - kj;
            const bool valid = (wid + i <= 15) && dist >= 0 && dist <= 128 && (n > 0 || kj >= 128);
            const float v = valid ? s[i][rg] * sc : -INFINITY; s[i][rg] = v; mx = fmaxf(mx, v); }
    mx = fmaxf(mx, __shfl_xor(mx, 16)); mx = fmaxf(mx, __shfl_xor(mx, 32));
    float sum = 0.f;
#pragma unroll
    for (int i = 0; i < 10; ++i)
#pragma unroll
        for (int rg = 0; rg < 4; ++rg) { const float e = __builtin_amdgcn_exp2f(s[i][rg] - mx); s[i][rg] = e; sum += e; }
    sum += __shfl_xor(sum, 16); sum += __shfl_xor(sum, 32);
    bf16x8 pf[5];
#pragma unroll
    for (int ks = 0; ks < 5; ++ks) { u32x4 w; w.x = cvt_pk_bf16(s[2 * ks][0], s[2 * ks][1]); w.y = cvt_pk_bf16(s[2 * ks][2], s[2 * ks][3]); w.z = cvt_pk_bf16(s[2 * ks + 1][0], s[2 * ks + 1][1]); w.w = cvt_pk_bf16(s[2 * ks + 1][2], s[2 * ks + 1][3]);
        pf[ks] = __builtin_bit_cast(bf16x8, w); }
    __syncthreads();
    f32x4 o[8];
#pragma unroll
    for (int dt = 0; dt < 8; ++dt) o[dt] = (f32x4){0.f, 0.f, 0.f, 0.f};
#pragma unroll
    for (int ks = 0; ks < 5; ++ks) { const int T0 = (wid + 2 * ks) < 15 ? (wid + 2 * ks) : 15, T1 = (wid + 2 * ks + 1) < 15 ? (wid + 2 * ks + 1) : 15;
        const LAS unsigned char* v0 = lds + (16 * T0 + 4 * kg + q4) * TSTR + 8 * p4;
        const LAS unsigned char* v1 = lds + (16 * T1 + 4 * kg + q4) * TSTR + 8 * p4;
#pragma unroll
        for (int dt = 0; dt < 8; ++dt) { const bf16x8 vf = cat4(lds_tr(v0 + 32 * dt), lds_tr(v1 + 32 * dt));
            o[dt] = __builtin_amdgcn_mfma_f32_16x16x32_bf16(vf, pf[ks], o[dt], 0, 0, 0); } }
    const float inv = 1.0f / sum; const int posq = qbase + (qi << dsh);
    bf16_t* orow = ATT + ((size_t)p * SEQ + posq) * 1024 + h * 128 + 4 * kg;
#pragma unroll
    for (int dt = 0; dt < 8; ++dt) { u32x2 w; w.x = cvt_pk_bf16(o[dt][0] * inv, o[dt][1] * inv); w.y = cvt_pk_bf16(o[dt][2] * inv, o[dt][3] * inv); *(u32x2*)(orow + 16 * dt) = w; }
    if (kg == 0) LSE[((size_t)p * 8 + h) * SEQ + posq] = mx * 0.6931471805599453f + __logf(sum);
    __syncthreads();
}

__device__ __forceinline__ void phase_mix(const Args& a, int l, LAS unsigned char* lds, int tid, int wid, int lane) {
    for (int uid = blockIdx.x; uid < 4096; uid += gridDim.x) {
        if (uid < 1024) sgu_unit(a, l, lds, uid, tid, wid, lane);
        else attn_unit(a, lds, uid - 1024, tid, wid, lane);
    }
}

__device__ __forceinline__ void phase_attcomb(const Args& a, int l, int wave, int lane) {
    const int gw = blockIdx.x * NWAVES + wave, NGW = gridDim.x * NWAVES;
    const bf16_t* ATT = (const bf16_t*)(a.ws + WS_ATT);
    const float* LSE = (const float*)(a.ws + WS_LSE);
    bf16_t* YM = (bf16_t*)(a.ws + WS_YMIX);
    const int h = lane >> 3, c0 = 16 * lane;
    float gn[16];
#pragma unroll
    for (int j = 0; j < 16; ++j) gn[j] = a.in[I_ONA][l * 1024 + c0 + j];
    for (int m = gw; m < SEQ; m += NGW) {
        float ls[3], o[16];
#pragma unroll
        for (int p = 0; p < 3; ++p) ls[p] = LSE[((size_t)p * 8 + h) * SEQ + m];
        const float mxl = fmaxf(ls[0], fmaxf(ls[1], ls[2]));
        float al[3], asum = 0.f;
#pragma unroll
        for (int p = 0; p < 3; ++p) { al[p] = __expf(ls[p] - mxl); asum += al[p]; }
        const float ainv = 1.0f / asum;
#pragma unroll
        for (int j = 0; j < 16; ++j) o[j] = 0.f;
#pragma unroll
        for (int p = 0; p < 3; ++p) { const bf16_t* src = ATT + ((size_t)p * SEQ + m) * 1024 + c0; float t[8]; const float w = al[p] * ainv;
            unpack8(*(const u32x4*)src, t);
#pragma unroll
            for (int j = 0; j < 8; ++j) o[j] += w * t[j];
            unpack8(*(const u32x4*)(src + 8), t);
#pragma unroll
            for (int j = 0; j < 8; ++j) o[8 + j] += w * t[j]; }
        float ss = 0.f;
#pragma unroll
        for (int j = 0; j < 16; ++j) ss += o[j] * o[j];
        ss += __shfl_xor(ss, 1); ss += __shfl_xor(ss, 2); ss += __shfl_xor(ss, 4);
        const float rstd = rsqrtf(ss * (1.0f / 128.0f) + NEPS);
        float t0[8], t1[8];
#pragma unroll
        for (int j = 0; j < 8; ++j) { t0[j] = o[j] * rstd * gn[j]; t1[j] = o[8 + j] * rstd * gn[8 + j]; }
        bf16_t* dst = YM + (size_t)m * DM + 1024 + c0;
        *(u32x4*)dst = pack8(t0); *(u32x4*)(dst + 8) = pack8(t1);
    }
}

constexpr int RSTR = 4112;
__device__ __forceinline__ void phase_router(const Args& a, int l, LAS unsigned char* lds, int tid, int wid, int lane) {
    const float* mod = (const float*)(a.ws + WS_CTL) + CW_MOD + l * 12288;
    const float* x1 = a.out;
    bf16_t* H = (bf16_t*)(a.ws + WS_H);
    LAS unsigned char* HHI = lds; LAS unsigned char* HLO = lds + 16 * RSTR;
    LAS float* LOG = (LAS float*)(lds + 32 * RSTR); LAS float* SEL = LOG + 1024;
    const bf16_t* RTH = (const bf16_t*)(a.ws + WS_RT) + (size_t)l * 262144; const bf16_t* RTL = RTH + 131072;
    unsigned* cnt = (unsigned*)(a.ws + WS_CTL) + CW_CNT + 64 * (l * 64);
    int* toklist = (int*)(a.ws + WS_TOKLIST); int* toksel = (int*)(a.ws + WS_TOKSEL); float* gwt = (float*)(a.ws + WS_GW);
    f32x4 ga[8], gb[8]; load_mod_vecs(a.in[I_FFNN] + l * DM, mod + 4 * 2048, mod + 3 * 2048, lane, ga, gb);
    const int fr = lane & 15, kg = lane >> 4;
    for (int tile = blockIdx.x; tile < SEQ / 16; tile += gridDim.x) {
#pragma unroll
        for (int rr = 0; rr < 2; ++rr) { const int r = 2 * wid + rr, m = 16 * tile + r;
            f32x4 v[8]; load_row(x1 + (size_t)m * DM, lane, v);
            const float rstd = rsqrtf(wave_sum(sumsq8(v)) * (1.0f / DM) + NEPS);
#pragma unroll
            for (int j = 0; j < 8; ++j) v[j] = v[j] * rstd * ga[j] + gb[j];
            store_row_bf16(H + (size_t)m * DM, lane, v);
#pragma unroll
            for (int j = 0; j < 4; ++j) { float f[8] = {v[2 * j][0], v[2 * j][1], v[2 * j][2], v[2 * j][3], v[2 * j + 1][0], v[2 * j + 1][1], v[2 * j + 1][2], v[2 * j + 1][3]};
                const u32x4 hi = pack8(f); float fh[8]; unpack8(hi, fh);
#pragma unroll
                for (int q = 0; q < 8; ++q) f[q] -= fh[q];
                const u32x4 lo = pack8(f);
                *(LAS u32x4*)(HHI + r * RSTR + 16 * (64 * j + lane)) = hi; *(LAS u32x4*)(HLO + r * RSTR + 16 * (64 * j + lane)) = lo; } }
        __syncthreads();
        {
            f32x4 acc[4];
#pragma unroll
            for (int nt = 0; nt < 4; ++nt) acc[nt] = (f32x4){0.f, 0.f, 0.f, 0.f};
#pragma unroll 2
            for (int ks = 0; ks < 8; ++ks) { const int k0 = 256 * wid + 32 * ks + 8 * kg;
                const bf16x8 ah = *(const LAS bf16x8*)(HHI + fr * RSTR + k0 * 2), al = *(const LAS bf16x8*)(HLO + fr * RSTR + k0 * 2);
#pragma unroll
                for (int nt = 0; nt < 4; ++nt) { const bf16x8 bh = *(const bf16x8*)(RTH + (size_t)(16 * nt + fr) * 2048 + k0), bl = *(const bf16x8*)(RTL + (size_t)(16 * nt + fr) * 2048 + k0);
                    acc[nt] = __builtin_amdgcn_mfma_f32_16x16x32_bf16(ah, bh, acc[nt], 0, 0, 0);
                    acc[nt] = __builtin_amdgcn_mfma_f32_16x16x32_bf16(ah, bl, acc[nt], 0, 0, 0);
                    acc[nt] = __builtin_amdgcn_mfma_f32_16x16x32_bf16(al, bh, acc[nt], 0, 0, 0); } }
            __syncthreads();
            LAS float* PART = (LAS float*)lds + wid * 1024;
#pragma unroll
            for (int nt = 0; nt < 4; ++nt)
#pragma unroll
                for (int rg = 0; rg < 4; ++rg) PART[(4 * kg + rg) * 64 + 16 * nt + fr] = acc[nt][rg];
        }
        __syncthreads();
        if (tid < 16) {
            const int tt = tid, m = 16 * tile + tt;
            LAS float* lg = LOG + tt * 64; LAS float* sl = SEL + tt * 64;
            for (int e = 0; e < 64; ++e) { float lgt = 0.f;
#pragma unroll
                for (int w = 0; w < 8; ++w) lgt += ((const LAS float*)lds)[w * 1024 + tt * 64 + e];
                const float s = 1.0f / (1.0f + __expf(-lgt)); lg[e] = s; sl[e] = s + a.in[I_RB][l * 64 + e]; }
            float gsc[8];
#pragma unroll
            for (int g = 0; g < 8; ++g) { float m1 = -INFINITY, m2 = -INFINITY;
                for (int j = 0; j < 8; ++j) { const float v = sl[8 * g + j]; if (v > m1) { m2 = m1; m1 = v; } else if (v > m2) m2 = v; }
                gsc[g] = m1 + m2; }
            unsigned gmask = 0u;
#pragma unroll
            for (int it = 0; it < 4; ++it) { float best = -INFINITY; int bi = 0;
#pragma unroll
                for (int g = 0; g < 8; ++g) { const bool free = !((gmask >> g) & 1u); if (free && gsc[g] > best) { best = gsc[g]; bi = g; } }
                gmask |= 1u << bi; }
            int idx[8]; float wv[8]; float wsum = 0.f;
#pragma unroll
            for (int k = 0; k < 8; ++k) { float best = -INFINITY; int bi = 0;
                for (int e = 0; e < 64; ++e) { const float v = sl[e]; if (((gmask >> (e >> 3)) & 1u) && v > best) { best = v; bi = e; } }
                idx[k] = bi; wv[k] = lg[bi]; wsum += wv[k]; sl[bi] = -INFINITY; }
            const float wn = 2.5f / wsum;
#pragma unroll
            for (int k = 0; k < 8; ++k) { const int e = idx[k]; const unsigned pos = atomicAdd(cnt + 64 * e, 1u);
                toklist[e * SEQ + (int)pos] = m; toksel[m * 8 + k] = e * SEQ + (int)pos; gwt[m * 8 + k] = wv[k] * wn; }
        }
        __syncthreads();
    }
}

__device__ __forceinline__ void build_tables(const Args& a, int l, LAS unsigned char* lds, int tid) {
    LAS int* seg = (LAS int*)(lds + LDS_TAB); LAS int* tpre = (LAS int*)(lds + LDS_TAB + 512);
    if (tid == 0) {
        const unsigned* cnt = (const unsigned*)(a.ws + WS_CTL) + CW_CNT + 64 * (l * 64);
        int s = 0, t = 0;
        for (int e = 0; e < 64; ++e) { const int c = (int)__hip_atomic_load(cnt + 64 * e, __ATOMIC_RELAXED, __HIP_MEMORY_SCOPE_AGENT); const int nt = (c + 255) >> 8; seg[e] = s; tpre[e] = t; s += nt * 256; t += nt; }
        seg[64] = s; tpre[64] = t; tpre[65] = t + 64;
    }
    __syncthreads();
}

__device__ __forceinline__ void phase_combine(const Args& a, int l, int wave, int lane) {
    const int gw = blockIdx.x * NWAVES + wave, NGW = gridDim.x * NWAVES;
    const float* mod = (const float*)(a.ws + WS_CTL) + CW_MOD + l * 12288;
    const bf16_t* Y = (const bf16_t*)(a.ws + WS_Y);
    const int* toksel = (const int*)(a.ws + WS_TOKSEL); const float* gwt = (const float*)(a.ws + WS_GW);
    const unsigned* cnt = (const unsigned*)(a.ws + WS_CTL) + CW_CNT + 64 * (l * 64);
    bf16_t* H = (bf16_t*)(a.ws + WS_H);
    int myc = (((int)__hip_atomic_load(cnt + 64 * lane, __ATOMIC_RELAXED, __HIP_MEMORY_SCOPE_AGENT) + 255) >> 8) << 8, incl = myc;
#pragma unroll
    for (int o = 1; o < 64; o <<= 1) { const int t = __shfl_up(incl, o); if (lane >= o) incl += t; }
    const int segstart = incl - myc; const int segsh = __shfl(incl, 63);
    f32x4 gf[8]; load_row(mod + 5 * 2048, lane, gf);
    f32x4 ga[8], gb[8];
    if (l == 0) { const float* mod1 = mod + 12288; load_mod_vecs(a.in[I_MIXN] + DM, mod1 + 2048, mod1, lane, ga, gb); }
    for (int m = gw; m < SEQ; m += NGW) {
        f32x4 v[8], yacc[8]; load_row(a.out + (size_t)m * DM, lane, v);
#pragma unroll
        for (int j = 0; j < 8; ++j) yacc[j] = (f32x4){0.f, 0.f, 0.f, 0.f};
#pragma unroll
        for (int k = 0; k < 9; ++k) {
            int slot; float w;
            if (k < 8) { const int ts = toksel[m * 8 + k]; const int e = ts >> 14, pos = ts & 16383; slot = __shfl(segstart, e) + pos; w = gwt[m * 8 + k]; }
            else { slot = segsh + m; w = 1.0f; }
            const bf16_t* yr = Y + (size_t)slot * DM;
#pragma unroll
            for (int j = 0; j < 4; ++j) { float t[8]; unpack8(*(const u32x4*)(yr + 8 * (64 * j + lane)), t);
                yacc[2 * j] += (f32x4){t[0], t[1], t[2], t[3]} * w; yacc[2 * j + 1] += (f32x4){t[4], t[5], t[6], t[7]} * w; }
        }
#pragma unroll
        for (int j = 0; j < 8; ++j) v[j] = v[j] + gf[j] * yacc[j];
#pragma unroll
        for (int j = 0; j < 4; ++j) { f32x4* p = (f32x4*)(a.out + (size_t)m * DM + 8 * (64 * j + lane)); p[0] = v[2 * j]; p[1] = v[2 * j + 1]; }
        if (l == 0) {
            const float rstd = rsqrtf(wave_sum(sumsq8(v)) * (1.0f / DM) + NEPS);
#pragma unroll
            for (int j = 0; j < 8; ++j) v[j] = v[j] * rstd * ga[j] + gb[j];
            store_row_bf16(H + (size_t)m * DM, lane, v);
        }
    }
}

constexpr int NPHASE = 22;
__global__ void __launch_bounds__(NTHREADS, 2) trunk_fwd(Args args) {
    extern __shared__ __attribute__((aligned(16))) unsigned char lds_raw[];
    LAS unsigned char* lds = (LAS unsigned char*)lds_raw;
    const int tid = threadIdx.x, lane = tid & 63, wave = __builtin_amdgcn_readfirstlane(tid >> 6);
    volatile LAS unsigned* MISC = (volatile LAS unsigned*)(lds + LDS_MISC);
    if (tid < 64) ((LAS unsigned*)(lds + LDS_MISC))[tid] = 0u;
    __syncthreads();
    unsigned* ctl = (unsigned*)(args.ws + WS_CTL);
    XcdBarrier bar = xcd_barrier_post(ctl + CW_BAR, MISC);
    const int lo = args.ph_lo, hi = args.ph_hi;
#define IN(k) (lo <= (k) && (k) < hi)
#define PBEGIN int ptid = tid; asm volatile("" : "+v"(ptid)); const int plane = ptid & 63; const int pwave = __builtin_amdgcn_readfirstlane(ptid >> 6); (void)plane; (void)pwave;
#define SEAM(k) do { if (IN(k) && IN((k) + 1)) xcd_barrier(bar); } while (0)
    bf16_t* H = (bf16_t*)(args.ws + WS_H);
    bf16_t* PROJ = (bf16_t*)(args.ws + WS_PROJ);
    bf16_t* YMIX = (bf16_t*)(args.ws + WS_YMIX);
    bf16_t* HID = (bf16_t*)(args.ws + WS_HID);
    bf16_t* Y = (bf16_t*)(args.ws + WS_Y);
    const int G = gridDim.x;

    if (IN(0)) { PBEGIN phase_prologue(args, lds, ptid, pwave, plane); }
    SEAM(0);
    if (IN(1)) { PBEGIN phase_modreduce(args, ptid); }
    SEAM(1);
    for (int l = 0; l < NLAYER; ++l) {
        const int pb = 2 + 10 * l;
        unsigned char* wl = args.ws + WS_W + (size_t)l * W_LAYER;
        const float* mod = (const float*)(args.ws + WS_CTL) + CW_MOD + l * 12288;
        if (IN(pb + 0)) { PBEGIN if (l == 0) phase_norm1(args, 0, args.in[I_X], pwave, plane); }
        if (l == 0) SEAM(pb + 0);
        if (IN(pb + 1)) { PBEGIN pg8::DenseSched S; S.init(H, wl + W_IN, SEQ, DIN, DM, G, (int)blockIdx.x); pg8::EpiBf16 E{PROJ, DIN, (const LAS int*)(lds + LDS_TAB), 0};
            pg8::gemm_phase<pg8::EpiBf16, pg8::DenseSched>(lds, DM, S, E, ptid); }
        SEAM(pb + 1);
        if (IN(pb + 2)) { PBEGIN phase_post(args, l, pwave, plane); }
        SEAM(pb + 2);
        if (IN(pb + 3)) { PBEGIN phase_mix(args, l, lds, ptid, pwave, plane); }
        SEAM(pb + 3);
        if (IN(pb + 4)) { PBEGIN phase_attcomb(args, l, pwave, plane); }
        SEAM(pb + 4);
        if (IN(pb + 5)) { PBEGIN pg8::DenseSched S; S.init(YMIX, wl + W_OUT, SEQ, DM, DM, G, (int)blockIdx.x); pg8::EpiResid E{l == 0 ? args.in[I_X] : args.out, args.out, mod + 2 * 2048};
            pg8::gemm_phase<pg8::EpiResid, pg8::DenseSched>(lds, DM, S, E, ptid); }
        SEAM(pb + 5);
        if (IN(pb + 6)) { PBEGIN phase_router(args, l, lds, ptid, pwave, plane); }
        SEAM(pb + 6);
        if (IN(pb + 7)) {
            PBEGIN
            build_tables(args, l, lds, ptid);
            const LAS int* seg = (const LAS int*)(lds + LDS_TAB); const LAS int* tpre = (const LAS int*)(lds + LDS_TAB + 512); LAS int* toks = (LAS int*)(lds + LDS_TOK);
            typedef pg8::GroupSched<DM, 4, true> SchedGU; SchedGU S; S.A = (const char*)H; S.Bt = (const char*)(wl + W_GU); S.seg = seg; S.tpre = tpre; S.toks = toks; S.G = G; S.c = (int)blockIdx.x;
            const unsigned* cnt = (const unsigned*)(args.ws + WS_CTL) + CW_CNT + 64 * (l * 64); const int* toklist = (const int*)(args.ws + WS_TOKLIST);
            { pg8::Unit u;
#pragma unroll 1
              for (int i = 0; i < 14 && S.next(i, u); ++i) { const int c = (u.e < 64) ? (int)__hip_atomic_load(cnt + 64 * u.e, __ATOMIC_RELAXED, __HIP_MEMORY_SCOPE_AGENT) : SEQ;
                  for (int r = ptid; r < 256; r += NTHREADS) { const int rr = u.pm * 256 + r; toks[i * 256 + r] = (rr < c) ? ((u.e < 64) ? toklist[u.e * SEQ + rr] : rr) : 0; } } }
            __syncthreads();
            pg8::EpiGateUp E{HID, seg};
            pg8::gemm_phase<pg8::EpiGateUp, SchedGU>(lds, DM, S, E, ptid);
        }
        SEAM(pb + 7);
        if (IN(pb + 8)) {
            PBEGIN
            build_tables(args, l, lds, ptid);
            const LAS int* seg = (const LAS int*)(lds + LDS_TAB); const LAS int* tpre = (const LAS int*)(lds + LDS_TAB + 512);
            typedef pg8::GroupSched<512, 8, false> SchedD; SchedD S; S.A = (const char*)HID; S.Bt = (const char*)(wl + W_D); S.seg = seg; S.tpre = tpre; S.toks = tpre; S.G = G; S.c = (int)blockIdx.x;
            pg8::EpiBf16 E{Y, DM, seg, 1};
            pg8::gemm_phase<pg8::EpiBf16, SchedD>(lds, 512, S, E, ptid);
        }
        SEAM(pb + 8);
        if (IN(pb + 9)) { PBEGIN phase_combine(args, l, pwave, plane); }
        if (l == 0) SEAM(pb + 9);
    }
#undef IN
#undef SEAM
}

extern "C" void kernel_launch(void* const* d_in, const int* in_sizes, int n_in, void* d_out, int out_size, void* d_ws, size_t ws_size, hipStream_t stream) {
    static int grid = 0;
    if (grid == 0) {
        if (n_in != 23 || out_size != SEQ * DM || ws_size < WS_END) { fprintf(stderr, "kernel_launch: unexpected shapes (n_in %d, out %d, ws %zu < %zu)\n", n_in, out_size, ws_size, (size_t)WS_END); grid = -1; return; }
        int dev = 0, cus = 0, per_cu = 0;
        if (hipGetDevice(&dev) != hipSuccess || hipDeviceGetAttribute(&cus, hipDeviceAttributeMultiprocessorCount, dev) != hipSuccess) { grid = -1; return; }
        if (hipFuncSetAttribute((const void*)trunk_fwd, hipFuncAttributeMaxDynamicSharedMemorySize, LDS_BYTES) != hipSuccess) { fprintf(stderr, "kernel_launch: hipFuncSetAttribute failed\n"); grid = -1; return; }
        if (hipOccupancyMaxActiveBlocksPerMultiprocessor(&per_cu, (const void*)trunk_fwd, NTHREADS, LDS_BYTES) != hipSuccess || per_cu < 1) { fprintf(stderr, "kernel_launch: occupancy query says %d\n", per_cu); }
        (void)hipGetLastError();
        grid = cus;
    }
    if (grid < 0) return;
    (void)hipMemsetAsync((char*)d_ws + WS_CTL, 0, CTL_BYTES, stream);
    Args a{};
    for (int i = 0; i < 23; ++i) a.in[i] = (const float*)d_in[i];
    a.out = (float*)d_out; a.ws = (unsigned char*)d_ws;
#if N_LAUNCH_MODE == 1
    a.ph_lo = 0; a.ph_hi = NPHASE;
    hipLaunchKernelGGL(trunk_fwd, dim3(grid), dim3(NTHREADS), LDS_BYTES, stream, a);
#else
    for (int ph = 0; ph < NPHASE; ++ph) {
        if (ph == 12) continue;
        a.ph_lo = ph; a.ph_hi = ph + 1;
        hipLaunchKernelGGL(trunk_fwd, dim3(grid), dim3(NTHREADS), LDS_BYTES, stream, a);
    }
#endif
}
```

```cpp
#include <hip/hip_runtime.h>
#include <cstdio>
#include <cstdint>
#include <cmath>

#ifndef PROBE_NOSTORE
#define PROBE_NOSTORE 0
#endif
#ifndef ATT_PIPE
#define ATT_PIPE 1
#endif
#ifndef ATT_CLEAR
#define ATT_CLEAR 0
#endif
#ifndef ATT_CHK_TILE
#define ATT_CHK_TILE 99
#endif
#ifndef ATT_VOLD
#define ATT_VOLD 0
#endif
#ifndef ATT_KGLOBAL
#define ATT_KGLOBAL 0
#endif
#ifndef DIAG_P
#define DIAG_P 0
#endif
#ifndef DIAG_SGU
#define DIAG_SGU 1
#endif
#ifndef DIAG_NOTR
#define DIAG_NOTR 1
#endif
#ifndef DIAG_STOP
#define DIAG_STOP -1
#endif
#ifndef WIN_FP8
#define WIN_FP8 1
#endif
#ifndef WOUT_FP8
#define WOUT_FP8 1
#endif
#ifndef STAG_D
#define STAG_D 0
#endif
#ifndef STAG_GU
#define STAG_GU 0
#endif
#ifndef GROUP_XCD
#define GROUP_XCD 0
#endif
#ifndef GROUP_PERM
#define GROUP_PERM 1
#endif
#ifndef N_LAUNCH_MODE
#define N_LAUNCH_MODE 1
#endif

#define LAS __attribute__((address_space(3)))
typedef unsigned short bf16_t;
typedef short bf16x8 __attribute__((ext_vector_type(8)));
typedef short s16x4 __attribute__((ext_vector_type(4)));
typedef float f32x4 __attribute__((ext_vector_type(4)));
typedef float f32x2 __attribute__((ext_vector_type(2)));
typedef unsigned u32x4 __attribute__((ext_vector_type(4)));
typedef unsigned u32x2 __attribute__((ext_vector_type(2)));

constexpr int SEQ = 16384, DM = 2048, DIN = 5120, NEXP = 64, NEXS = 65, NLAYER = 2;
constexpr float NEPS = 1e-6f;
constexpr float WSC_GU = 64.f, WSC_D = 32.f, ASC_H = 8.f, ASC_HID = 8.f, YSC = 16.f;
constexpr int NWAVES = 8, NTHREADS = 512;
constexpr int HID_ROWS = 131072 + 64 * 256 + 16384;

constexpr size_t MiB = 1u << 20;
constexpr size_t WS_CTL = 0, CTL_BYTES = 1 * MiB;
constexpr int CW_BAR = 4096;
constexpr int CW_CNT = 8192;
constexpr int CW_MOD = 32768;
constexpr size_t WS_ROPE = 1 * MiB;
constexpr size_t WS_SGUW = 3 * MiB;
constexpr size_t WS_RT = 4 * MiB;
constexpr size_t WS_TOKLIST = 5 * MiB;
constexpr size_t WS_TOKSEL = 9 * MiB;
constexpr size_t WS_GW = 9 * MiB + 512 * 1024;
constexpr size_t WS_LSE = 10 * MiB;
constexpr size_t WS_MODP = 11 * MiB + 512 * 1024;
constexpr size_t WS_W = 16 * MiB;
constexpr size_t W_IN = 0, W_OUT = 20 * MiB, W_GU = 28 * MiB, W_D = W_GU + 65 * 4 * MiB, W_LAYER = W_D + 65 * 2 * MiB;
constexpr size_t WS_H = WS_W + 2 * W_LAYER;
constexpr size_t WS_HID = WS_H + 64 * MiB;
constexpr size_t WS_Y = WS_HID + (size_t)HID_ROWS * 1024;
constexpr size_t WS_PROJ = WS_Y;
constexpr size_t WS_YMIX = WS_PROJ + 160 * MiB;
constexpr size_t WS_ATT = WS_YMIX + 64 * MiB;
constexpr size_t WS_MIXD = WS_Y + 320 * MiB;
constexpr size_t WS_END = WS_Y + (size_t)HID_ROWS * 4096;
static_assert(WS_ATT + 96 * MiB <= WS_END, "overlay");
constexpr size_t WS_DUMMY = WS_END;
constexpr size_t WS_XR = WS_DUMMY;
constexpr size_t WS_XB = WS_DUMMY + 64 * MiB;
constexpr size_t WS_NEED = WS_END + 300 * MiB;

constexpr int LDS_BYTES = 147456;
constexpr int LDS_TAB = 131072;
constexpr int LDS_TOK = 133120;
constexpr int TOK_CAP = 13;
constexpr int LDS_MISC = 147200;

__device__ __forceinline__ unsigned cvt_pk_bf16(float lo, float hi) { unsigned r; asm volatile("v_cvt_pk_bf16_f32 %0, %1, %2" : "=v"(r) : "v"(lo), "v"(hi)); return r; }
__device__ __forceinline__ float bf_lo(unsigned w) { return __uint_as_float(w << 16); }
__device__ __forceinline__ float bf_hi(unsigned w) { return __uint_as_float(w & 0xffff0000u); }
__device__ __forceinline__ float bf2f(bf16_t b) { return __uint_as_float(((unsigned)b) << 16); }
__device__ __forceinline__ float shx(float v, int m, int lane) { return __int_as_float(__builtin_amdgcn_ds_bpermute((lane ^ m) << 2, __float_as_int(v))); }
__device__ __forceinline__ float shl_f(float v, int src) { return __int_as_float(__builtin_amdgcn_ds_bpermute(src << 2, __float_as_int(v))); }
__device__ __forceinline__ int shl_i(int v, int src) { return __builtin_amdgcn_ds_bpermute(src << 2, v); }
__device__ __forceinline__ float wave_sum(float v, int lane) {
#pragma unroll
    for (int o = 1; o < 64; o <<= 1) v += shx(v, o, lane);
    return v;
}
__device__ __forceinline__ f32x2 gelu_pk(f32x2 v) {
    const f32x2 av = __builtin_elementwise_abs(v), d = av * 0.2316418882f + 1.0f;
    f32x2 t; t.x = __builtin_amdgcn_rcpf(d.x); t.y = __builtin_amdgcn_rcpf(d.y);
    f32x2 q = t * 0.5307027145f + (-0.7265760135f); q = q * t + 0.7107068705f; q = q * t + (-0.142248368f); q = q * t + 0.127414796f; q = q * t;
    const f32x2 s = (v * v) * (-0.72134752044f);
    f32x2 e; e.x = __builtin_amdgcn_exp2f(s.x); e.y = __builtin_amdgcn_exp2f(s.y);
    const f32x2 m = v * (q * e), r = v - m;
    f32x2 o; o.x = v.x < 0.f ? m.x : r.x; o.y = v.y < 0.f ? m.y : r.y; return o;
}
__device__ __forceinline__ float gelu1(float x) { f32x2 v = {x, 0.f}; return gelu_pk(v).x; }
__device__ __forceinline__ float silu1(float x) { return x * __builtin_amdgcn_rcpf(1.0f + __expf(-x)); }
__device__ __forceinline__ s16x4 lds_tr(const LAS unsigned char* p) { return __builtin_bit_cast(s16x4, __builtin_amdgcn_ds_read_tr16_b64_v4i16((LAS s16x4*)p)); }
__device__ __forceinline__ bf16x8 cat4(s16x4 a, s16x4 b) { bf16x8 r; r[0] = a[0]; r[1] = a[1]; r[2] = a[2]; r[3] = a[3]; r[4] = b[0]; r[5] = b[1]; r[6] = b[2]; r[7] = b[3]; return r; }
__device__ __forceinline__ unsigned pk4_fp8(float a, float b, float c, float d) {
    a = fminf(fmaxf(a, -448.f), 448.f); b = fminf(fmaxf(b, -448.f), 448.f); c = fminf(fmaxf(c, -448.f), 448.f); d = fminf(fmaxf(d, -448.f), 448.f);
    int w = 0; w = __builtin_amdgcn_cvt_pk_fp8_f32(a, b, w, false); w = __builtin_amdgcn_cvt_pk_fp8_f32(c, d, w, true); return (unsigned)w; }
__device__ __forceinline__ void unpack8(const u32x4 w, float (&f)[8]) { f[0] = bf_lo(w.x); f[1] = bf_hi(w.x); f[2] = bf_lo(w.y); f[3] = bf_hi(w.y); f[4] = bf_lo(w.z); f[5] = bf_hi(w.z); f[6] = bf_lo(w.w); f[7] = bf_hi(w.w); }
__device__ __forceinline__ u32x4 pack8(const float (&f)[8]) { u32x4 w; w.x = cvt_pk_bf16(f[0], f[1]); w.y = cvt_pk_bf16(f[2], f[3]); w.z = cvt_pk_bf16(f[4], f[5]); w.w = cvt_pk_bf16(f[6], f[7]); return w; }

#define XB_TMO      128
#define XB_XCNT(j)  (256  + 64 * (j))
#define XB_XSUB(j)  (1280 + 64 * (j))
#define XB_XGEN(j)  (2304 + 64 * (j))
#define XB_TOP      3328
#define XB_TOPGEN   3392
#define XCD_BAR_WORDS 3456
#define XB_SPIN_CAP (1u << 18)
__device__ __forceinline__ unsigned xb_ld(unsigned* p)              { return __hip_atomic_load(p, __ATOMIC_RELAXED, __HIP_MEMORY_SCOPE_AGENT); }
__device__ __forceinline__ unsigned xb_add(unsigned* p, unsigned v) { return __hip_atomic_fetch_add(p, v, __ATOMIC_RELAXED, __HIP_MEMORY_SCOPE_AGENT); }
__device__ __forceinline__ unsigned xb_xcc_id() { return (unsigned)__builtin_amdgcn_s_getreg((3 << 11) | 20) & 0xFu; }
#define XB_SPIN(cond, bar) do { unsigned _sp = 0; while (cond) { __builtin_amdgcn_s_sleep(1); \
    if ((++_sp & 255u) == 0u) { if (xb_ld(&(bar)[XB_TMO])) break; if (_sp > XB_SPIN_CAP) { atomicAdd(&(bar)[XB_TMO], 1u); break; } } } } while (0)
struct XcdBarrier { unsigned* bar; unsigned x; volatile LAS unsigned* st; };
__device__ __forceinline__ XcdBarrier xcd_barrier_post(unsigned* bar, volatile LAS unsigned* st) {
    XcdBarrier b; b.bar = bar; b.x = xb_xcc_id(); b.st = st;
    if (threadIdx.x == 0) (void)xb_add(&bar[XB_XCNT(b.x)], 1u);
    return b;
}
__device__ __forceinline__ void xcd_barrier_complete(unsigned* bar, unsigned x, unsigned& nloc, unsigned& nx) {
    const unsigned G = gridDim.x * gridDim.y * gridDim.z;
    unsigned sum, cnt, mine, sp = 0u;
    for (;;) {
        sum = 0u; cnt = 0u; mine = 0u;
#pragma unroll
        for (unsigned j = 0; j < 16; ++j) { const unsigned c = xb_ld(&bar[XB_XCNT(j)]); sum += c; cnt += (c > 0u) ? 1u : 0u; mine = (j == x) ? c : mine; }
        if (sum == G) break;
        __builtin_amdgcn_s_sleep(1);
        if ((++sp & 255u) == 0u) { if (xb_ld(&bar[XB_TMO])) break; if (sp > XB_SPIN_CAP) { atomicAdd(&bar[XB_TMO], 1u); break; } }
    }
    nloc = mine > 0u ? mine : 1u; nx = cnt > 0u ? cnt : 1u;
}
__device__ __forceinline__ void xcd_barrier(const XcdBarrier& b) {
    asm volatile("s_waitcnt vmcnt(0)" ::: "memory");
    __syncthreads();
    if (threadIdx.x == 0) {
        unsigned* bar = b.bar;
        __builtin_amdgcn_s_waitcnt(0);
        unsigned nloc = b.st[0], nx = b.st[1];
        if (nloc == 0u) { xcd_barrier_complete(bar, b.x, nloc, nx); b.st[0] = nloc; b.st[1] = nx; }
        const unsigned old = xb_add(&bar[XB_XSUB(b.x)], 1u);
        const unsigned gen = old / nloc;
        if (old + 1u == (gen + 1u) * nloc) {
            __builtin_amdgcn_fence(__ATOMIC_RELEASE, "agent");
            asm volatile("s_waitcnt vmcnt(0)" ::: "memory");
            const unsigned og = xb_add(&bar[XB_TOP], 1u);
            const unsigned tg = og / nx;
            if (og + 1u == (tg + 1u) * nx) xb_add(&bar[XB_TOPGEN], 1u);
            else XB_SPIN(xb_ld(&bar[XB_TOPGEN]) == tg, bar);
            __builtin_amdgcn_fence(__ATOMIC_ACQUIRE, "agent");
            xb_add(&bar[XB_XGEN(b.x)], 1u);
            asm volatile("s_waitcnt vmcnt(0)" ::: "memory");
        } else {
            XB_SPIN(xb_ld(&bar[XB_XGEN(b.x)]) == gen, bar);
            __builtin_amdgcn_fence(__ATOMIC_ACQUIRE, "agent");
            asm volatile("s_waitcnt vmcnt(0)" ::: "memory");
        }
    }
    __syncthreads();
}

namespace pg8 {
typedef int v8i __attribute__((ext_vector_type(8)));
__device__ __forceinline__ v8i cat8(bf16x8 a, bf16x8 b) { typedef int v4i __attribute__((ext_vector_type(4))); const v4i x = __builtin_bit_cast(v4i, a), y = __builtin_bit_cast(v4i, b); return __builtin_shufflevector(x, y, 0, 1, 2, 3, 4, 5, 6, 7); }
constexpr int BM = 256, BK = 64, HALF = 128, HTB = HALF * BK * 2, STAGE_BYTES = 8 * HTB, NXCD = 8, WGM = 8;
__host__ __device__ __forceinline__ int lds_byte(int r, int c) { return (r >> 3) * 1024 + (r & 7) * 128 + ((((c >> 3) ^ (r >> 1)) & 7) << 4) + (c & 7) * 2; }
__host__ __device__ __forceinline__ void stage_rc(int b, int& R, int& C) { const int blk = b / 1024, rr = (b % 1024) / 128, cp = (b % 128) / 16; R = blk * 8 + rr; C = ((cp ^ (R >> 1)) & 7) * 8; }
__host__ __device__ __forceinline__ int perm32(int rho) { const int n = rho >> 4, i = rho & 15; return 8 * (i >> 2) + 4 * n + (i & 3); }

struct Unit { int pm, pn, e, ord; };

struct DenseSched {
    static constexpr bool GATHER = false;
    const char* A; const char* Bt; int K, nM, nN, nwg, G, c;
    __device__ void init(const void* A_, const void* Bt_, int M, int N, int K_, int G_, int c_) { A = (const char*)A_; Bt = (const char*)Bt_; K = K_; nM = M / BM; nN = N / BM; nwg = nM * nN; G = G_; c = c_; }
    __device__ __forceinline__ bool next(int i, Unit& u) const {
        const long L = (long)i * G + c; if (L >= nwg) return false;
        int wgid = (int)L; { const int q = nwg / NXCD, r = nwg % NXCD, xcd = wgid % NXCD, off = wgid / NXCD; wgid = (xcd < r ? xcd * (q + 1) : r * (q + 1) + (xcd - r) * q) + off; }
        const int nig = WGM * nN, gid = wgid / nig, fm = gid * WGM, gsz = (nM - fm) < WGM ? (nM - fm) : WGM;
        u.pm = fm + ((wgid % nig) % gsz); u.pn = (wgid % nig) / gsz; u.e = 0; u.ord = i; return true;
    }
    __device__ __forceinline__ void locate(const Unit& u, const char*& a, const char*& b) const { a = A + (size_t)u.pm * BM * K * 2; b = Bt + (size_t)u.pn * BM * K * 2; }
    __device__ __forceinline__ unsigned arow(const Unit&, int row) const { return (unsigned)(row * K) * 2u; }
};
template <int KK, int NTN, bool GATHER_>
struct GroupSched {
    static constexpr bool GATHER = GATHER_;
    const char* A; const char* Bt; const LAS int* seg; const LAS int* xpre_; const LAS int* toks; const int* toklist;
    int nv, nev, v, rank, W, sh_start;
    static constexpr size_t bstride = (size_t)NTN * BM * KK * 2;
    __device__ __forceinline__ void init(const LAS unsigned char* lds, int G, int c) {
        seg = (const LAS int*)(lds + LDS_TAB); xpre_ = (const LAS int*)(lds + LDS_TAB + 512);
        const LAS int* misc = (const LAS int*)(lds + LDS_TAB + 1536);
        nv = __builtin_amdgcn_readfirstlane(misc[0]); nev = __builtin_amdgcn_readfirstlane(misc[1]); sh_start = __builtin_amdgcn_readfirstlane(misc[2]);
        W = G / nv;
#if GROUP_XCD == 2
        v = c / W; rank = c % W;
#else
        v = c % nv; rank = c / nv;
#endif
#if GROUP_PERM
        if (G % NXCD == 0) rank = __builtin_amdgcn_readfirstlane((c % NXCD) * (G / NXCD) + c / NXCD);
#endif
    }
    __device__ __forceinline__ bool next(int i, Unit& u) const {
        unsigned xa = (unsigned)(size_t)xpre_; asm volatile("" : "+s"(xa)); const LAS int* xpre = (const LAS int*)(size_t)xa;
        const int q = rank + i * W; const int mtq = q / NTN; const int total = xpre[nev + 1];
        if (mtq >= total) return false;
        int k; { int ll; asm volatile("v_mbcnt_lo_u32_b32 %0, -1, 0\n\tv_mbcnt_hi_u32_b32 %0, -1, %0" : "=v"(ll));
            const int xv = (ll < nev) ? xpre[ll + 1] : 0x7fffffff;
            k = __builtin_popcountll(__builtin_amdgcn_ballot_w64(xv <= mtq)); }
        k = __builtin_amdgcn_readfirstlane(k);
        const int off = __builtin_amdgcn_readfirstlane(mtq - xpre[k]);
        if (k < nev) { u.e = v + nv * k; u.pm = off; } else { u.e = 64; u.pm = sh_start + off; }
        u.pn = q % NTN; u.ord = i; return true;
    }
    __device__ __forceinline__ void locate(const Unit& u, const char*& a, const char*& b) const {
        b = Bt + (size_t)u.e * bstride + (size_t)u.pn * BM * KK * 2;
        a = GATHER ? A : A + (size_t)(seg[u.e] + u.pm * BM) * KK * 2;
    }
    __device__ __forceinline__ unsigned arow(const Unit& u, int row) const {
        int t;
        if (u.ord < TOK_CAP) t = toks[u.ord * 256 + row];
        else { const int rr = u.pm * 256 + row; t = rr;
            if (u.e < 64) { const unsigned off = (unsigned)(u.e * SEQ + rr) * 4u; int tl;
                asm volatile("global_load_dword %0, %1, %2\n\ts_waitcnt vmcnt(0)" : "=&v"(tl) : "v"(off), "s"(toklist) : "memory");
                t = (rr < toks[TOK_CAP * 256 + u.e]) ? tl : 0; } }
        return (unsigned)t * (unsigned)(KK * 2);
    }
};

template <class Epi, class Sched, int STAG = 0, bool FP8 = false>
__device__ __forceinline__ void gemm_phase(LAS unsigned char* lds, const int K, const Sched& S, const Epi& E, const int tid) {
    if (STAG > 0) {
        const unsigned long long t0 = __builtin_amdgcn_s_memrealtime(); const unsigned long long target = (unsigned long long)(((blockIdx.x >> 3) & 3) * STAG);
        while (__builtin_amdgcn_s_memrealtime() - t0 < target) __builtin_amdgcn_s_sleep(8);
    }
    const int wid = __builtin_amdgcn_readfirstlane(tid >> 6), lane = tid & 63, wr = wid >> 2, wc = wid & 3, fr = lane & 15, fq = lane >> 4;
    const int nt = K / BK;
    constexpr bool GATHER = Sched::GATHER;
    unsigned voffB[2], vaC[2][2];
#define PG8_SETVB() do { int _t; asm volatile("v_mbcnt_lo_u32_b32 %0, -1, 0\n\tv_mbcnt_hi_u32_b32 %0, -1, %0" : "=v"(_t)); _t += wid * 64; _Pragma("unroll") for (int _i = 0; _i < 2; ++_i) { int _R, _C; stage_rc(_t * 16 + _i * 8192, _R, _C); \
        const int _Rb = Epi::PERM ? ((_R & ~31) + perm32(_R & 31)) : _R; voffB[_i] = (unsigned)(_Rb * K + _C) * 2u; if (!GATHER) vaC[0][_i] = (unsigned)(_R * K + _C) * 2u; } } while (0)
    const size_t kstep = (size_t)(BK * 2);
    const size_t hstepB = (size_t)HALF * K * 2;
#define PG8_SETVA(u) do { int _t; asm volatile("v_mbcnt_lo_u32_b32 %0, -1, 0\n\tv_mbcnt_hi_u32_b32 %0, -1, %0" : "=v"(_t)); _t += wid * 64; _Pragma("unroll") for (int _h = 0; _h < (GATHER ? 2 : 1); ++_h) _Pragma("unroll") for (int _i = 0; _i < 2; ++_i) { int _R, _C; stage_rc(_t * 16 + _i * 8192, _R, _C); \
        vaC[_h][_i] = (GATHER ? S.arow(u, _h * HALF + _R) : (unsigned)(_R * K) * 2u) + (unsigned)_C * 2u; } } while (0)
    const unsigned ldsw = (unsigned)wid * 1024u;
    const unsigned ldsb = (unsigned)(size_t)lds + ldsw;
    const int aoff = lds_byte(wr * 64 + fr, fq * 8), boff = lds_byte(wc * 32 + fr, fq * 8);
    unsigned abv = (unsigned)(size_t)lds + (unsigned)aoff, bbv = (unsigned)(size_t)lds + 65536u + (unsigned)boff; asm volatile("" : "+v"(abv), "+v"(bbv));
    const LAS unsigned char* abase = (const LAS unsigned char*)(size_t)abv; const LAS unsigned char* bbase = (const LAS unsigned char*)(size_t)bbv;
    unsigned abv2 = (unsigned)(size_t)lds + (unsigned)(aoff ^ 64), bbv2 = (unsigned)(size_t)lds + 65536u + (unsigned)(boff ^ 64); asm volatile("" : "+v"(abv2), "+v"(bbv2));
    const LAS unsigned char* abase2 = (const LAS unsigned char*)(size_t)abv2; const LAS unsigned char* bbase2 = (const LAS unsigned char*)(size_t)bbv2;
#define PG8_SA(b, h) (((b) * 2 + (h)) * HTB)
#define PG8_SB(b, h) ((4 + (b) * 2 + (h)) * HTB)
#define PG8_GLDS(sbase, voff, ldsaddr) do { unsigned _keep; asm volatile("s_mov_b32 %0, m0\n\ts_mov_b32 m0, %3\n\ts_nop 0\n\tglobal_load_lds_dwordx4 %1, %2\n\ts_mov_b32 m0, %0" : "=&s"(_keep) : "v"(voff), "s"(sbase), "s"(ldsaddr) : "memory"); } while (0)
#define PG8_STAGE_B(bufoff, gbase) do { _Pragma("unroll") for (int _i = 0; _i < 2; ++_i) PG8_GLDS((const char*)(gbase), voffB[_i], ldsb + (unsigned)((bufoff) + _i * 8192)); } while (0)
#define PG8_STAGE_A(bufoff, gbase, h) do { _Pragma("unroll") for (int _i = 0; _i < 2; ++_i) \
        PG8_GLDS((const char*)(gbase) + (GATHER ? (size_t)0 : (size_t)(h) * hstepB), vaC[GATHER ? (h) : 0][_i], ldsb + (unsigned)((bufoff) + _i * 8192)); } while (0)
#define PG8_LDA(dst, b, h) do { _Pragma("unroll") for (int m = 0; m < 4; ++m) { if constexpr (FP8) { dst##8[m] = cat8(*(const LAS bf16x8*)(abase + (PG8_SA(b, h) + m * 2048)), *(const LAS bf16x8*)(abase2 + (PG8_SA(b, h) + m * 2048))); } \
        else { _Pragma("unroll") for (int k = 0; k < 2; ++k) dst[m][k] = *(const LAS bf16x8*)((k ? abase2 : abase) + (PG8_SA(b, h) + m * 2048)); } } } while (0)
#define PG8_LDB(dst, b, h) do { _Pragma("unroll") for (int n = 0; n < 2; ++n) { if constexpr (FP8) { dst##8[n] = cat8(*(const LAS bf16x8*)(bbase + (PG8_SB(b, h) - 65536 + n * 2048)), *(const LAS bf16x8*)(bbase2 + (PG8_SB(b, h) - 65536 + n * 2048))); } \
        else { _Pragma("unroll") for (int k = 0; k < 2; ++k) dst[n][k] = *(const LAS bf16x8*)((k ? bbase2 : bbase) + (PG8_SB(b, h) - 65536 + n * 2048)); } } } while (0)
#define PG8_MMA(ai, bj, At, Bt) do { __builtin_amdgcn_s_setprio(1); _Pragma("unroll") for (int m = 0; m < 4; ++m) _Pragma("unroll") for (int n = 0; n < 2; ++n) { \
        if constexpr (FP8) { acc[ai][bj][m][n] = __builtin_amdgcn_mfma_scale_f32_16x16x128_f8f6f4(Bt##8[n], At##8[m], acc[ai][bj][m][n], 0, 0, 0, 0x7F7F7F7F, 0, 0x7F7F7F7F); } \
        else { _Pragma("unroll") for (int k = 0; k < 2; ++k) acc[ai][bj][m][n] = __builtin_amdgcn_mfma_f32_16x16x32_bf16(Bt[n][k], At[m][k], acc[ai][bj][m][n], 0, 0, 0); } } \
        __builtin_amdgcn_s_setprio(0); } while (0)
#define PG8_WAIT_V(n) asm volatile("s_waitcnt vmcnt(" #n ")" ::: "memory")
#define PG8_WAIT_L(n) asm volatile("s_waitcnt lgkmcnt(" #n ")" ::: "memory")
#define PG8_BAR __builtin_amdgcn_s_barrier()
#define PG8_SCHED __builtin_amdgcn_sched_barrier(0)
    Unit cur, nxt; int ui = 0;
    if (!S.next(0, cur)) return;
    f32x4 acc[2][2][4][2];
#pragma unroll
    for (int a = 0; a < 2; ++a)
#pragma unroll
        for (int b = 0; b < 2; ++b)
#pragma unroll
            for (int m = 0; m < 4; ++m)
#pragma unroll
                for (int n = 0; n < 2; ++n) acc[a][b][m][n] = (f32x4){0.f, 0.f, 0.f, 0.f};
    bf16x8 At[4][2], B0[2][2], B1[2][2]; v8i At8[4], B08[2], B18[2];
    const char* cA; const char* cB; S.locate(cur, cA, cB);
    PG8_SETVB();
    if (GATHER) PG8_SETVA(cur);
    PG8_STAGE_B(PG8_SB(0, 0), cB); PG8_STAGE_B(PG8_SB(0, 1), cB + hstepB); PG8_STAGE_A(PG8_SA(0, 0), cA, 0); PG8_STAGE_A(PG8_SA(0, 1), cA, 1);
    if (wr == 1) PG8_BAR;
    PG8_WAIT_V(2); PG8_BAR;
    PG8_STAGE_B(PG8_SB(1, 0), cB + kstep); PG8_STAGE_A(PG8_SA(1, 0), cA + kstep, 0); PG8_STAGE_B(PG8_SB(1, 1), cB + hstepB + kstep);
    PG8_WAIT_V(6); PG8_BAR;
    for (;;) {
        const bool has_next = S.next(ui + 1, nxt);
        const char* nA = cA; const char* nB = cB;
        if (has_next) S.locate(nxt, nA, nB);
#pragma unroll 1
        for (int t = 0; t < nt; t += 2) {
            const bool last = (t == nt - 2);
            asm volatile("" : "+s"(cA), "+s"(cB), "+s"(nA), "+s"(nB));
            PG8_SETVB();
            const char* a1 = cA + (size_t)(t + 1) * kstep;
            const char* a2 = last ? nA : cA + (size_t)(t + 2) * kstep; const char* b2 = last ? nB : cB + (size_t)(t + 2) * kstep;
            const char* a3 = a2 + kstep; const char* b3 = b2 + kstep;
            PG8_LDB(B0, 0, 0); PG8_LDB(B1, 0, 1); PG8_SCHED; PG8_LDA(At, 0, 0); PG8_STAGE_A(PG8_SA(1, 1), a1, 1);
            if (GATHER && last && has_next) PG8_SETVA(nxt);
            PG8_WAIT_V(8); PG8_WAIT_L(0); PG8_BAR; PG8_MMA(0, 0, At, B0); PG8_MMA(0, 1, At, B1); PG8_BAR; PG8_SCHED;
            PG8_LDA(At, 0, 1); PG8_STAGE_B(PG8_SB(0, 0), b2); PG8_STAGE_B(PG8_SB(0, 1), b2 + hstepB); PG8_STAGE_A(PG8_SA(0, 0), a2, 0);
            PG8_WAIT_V(8); PG8_WAIT_L(0); PG8_BAR; PG8_MMA(1, 0, At, B0); PG8_MMA(1, 1, At, B1); PG8_BAR; PG8_SCHED;
            PG8_LDB(B0, 1, 0); PG8_LDB(B1, 1, 1); PG8_SCHED; PG8_LDA(At, 1, 0); PG8_STAGE_A(PG8_SA(0, 1), a2, 1);
            PG8_WAIT_V(8); PG8_WAIT_L(0); PG8_BAR; PG8_MMA(0, 0, At, B0); PG8_MMA(0, 1, At, B1); PG8_BAR; PG8_SCHED;
            PG8_LDA(At, 1, 1); PG8_STAGE_B(PG8_SB(1, 0), b3); PG8_STAGE_B(PG8_SB(1, 1), b3 + hstepB); PG8_STAGE_A(PG8_SA(1, 0), a3, 0);
            PG8_WAIT_V(8); PG8_WAIT_L(0); PG8_BAR; PG8_MMA(1, 0, At, B0); PG8_MMA(1, 1, At, B1); PG8_BAR; PG8_SCHED;
        }
        if (wr == 0) PG8_BAR;
        { int l2; asm volatile("v_mbcnt_lo_u32_b32 %0, -1, 0\n\tv_mbcnt_hi_u32_b32 %0, -1, %0" : "=v"(l2));
          E(acc, cur, wid >> 2, wid & 3, l2 & 15, l2 >> 4); }
        if (!has_next) break;
#pragma unroll
        for (int a = 0; a < 2; ++a)
#pragma unroll
            for (int b = 0; b < 2; ++b)
#pragma unroll
                for (int m = 0; m < 4; ++m)
#pragma unroll
                    for (int n = 0; n < 2; ++n) acc[a][b][m][n] = (f32x4){0.f, 0.f, 0.f, 0.f};
        cur = nxt; cA = nA; cB = nB; ++ui;
        if (wr == 1) PG8_BAR;
    }
    PG8_WAIT_V(0);
    PG8_BAR;
#undef PG8_SA
#undef PG8_SB
#undef PG8_STAGE_A
#undef PG8_GLDS
#undef PG8_SETVA
#undef PG8_SETVB
#undef PG8_STAGE_B
#undef PG8_LDA
#undef PG8_LDB
#undef PG8_MMA
#undef PG8_WAIT_V
#undef PG8_WAIT_L
#undef PG8_BAR
#undef PG8_SCHED
}

struct EpiBf16 {
    static constexpr bool PERM = true;
    bf16_t* O; int ldc; const LAS int* seg; int grouped; int nostore; float scale;
    __device__ __forceinline__ void operator()(const f32x4 (&acc)[2][2][4][2], const Unit& u, int wr, int wc, int fr, int fq) const {
        const int rbase = (grouped ? seg[u.e] : 0) + u.pm * BM + wr * 64 + fr;
        const int col0 = u.pn * BM + wc * 32 + 8 * fq;
#pragma unroll
        for (int ai = 0; ai < 2; ++ai)
#pragma unroll
            for (int m = 0; m < 4; ++m) { bf16_t* rowp = O + (size_t)(rbase + ai * HALF + m * 16) * ldc + col0;
#pragma unroll
                for (int bj = 0; bj < 2; ++bj) { const f32x4 v0 = acc[ai][bj][m][0] * scale, v1 = acc[ai][bj][m][1] * scale;
                    u32x4 w; w.x = cvt_pk_bf16(v0[0], v0[1]); w.y = cvt_pk_bf16(v0[2], v0[3]); w.z = cvt_pk_bf16(v1[0], v1[1]); w.w = cvt_pk_bf16(v1[2], v1[3]);
                    *(u32x4*)(rowp + bj * HALF) = w; } }
    }
};
struct EpiProj {
    static constexpr bool PERM = true;
    bf16_t* O; const float* sgun; const float* qn; const float* kn; const float* rope; LAS float* SS;
    __device__ __forceinline__ void operator()(f32x4 (&acc)[2][2][4][2], const Unit& u, int wr, int wc, int fr, int fq) const {
        const int type = u.pn >> 2;
#if WIN_FP8
#pragma unroll
        for (int ai = 0; ai < 2; ++ai)
#pragma unroll
            for (int bj = 0; bj < 2; ++bj)
#pragma unroll
                for (int m = 0; m < 4; ++m)
#pragma unroll
                    for (int n = 0; n < 2; ++n) acc[ai][bj][m][n] = acc[ai][bj][m][n] * (1.0f / (ASC_H * WSC_GU));
#endif
        const int row0 = wr * 64 + fr;
        const int col0 = u.pn * BM + wc * 32 + 8 * fq;
        if (type == 0 || type == 1) {
#pragma unroll
            for (int ai = 0; ai < 2; ++ai)
#pragma unroll
                for (int bj = 0; bj < 2; ++bj)
#pragma unroll
                    for (int m = 0; m < 4; ++m)
#pragma unroll
                        for (int n = 0; n < 2; ++n) { const f32x4 v = acc[ai][bj][m][n]; const f32x2 a = gelu_pk((f32x2){v[0], v[1]}), b = gelu_pk((f32x2){v[2], v[3]}); acc[ai][bj][m][n] = (f32x4){a.x, a.y, b.x, b.y}; }
        }
        if (type >= 1 && type <= 3) {
            const int lane = fr + 16 * fq;
#pragma unroll
            for (int ai = 0; ai < 2; ++ai)
#pragma unroll
                for (int m = 0; m < 4; ++m)
#pragma unroll
                    for (int bj = 0; bj < 2; ++bj) { float ss = 0.f;
#pragma unroll
                        for (int n = 0; n < 2; ++n) { const f32x4 v = acc[ai][bj][m][n]; ss += (v[0] * v[0] + v[1] * v[1]) + (v[2] * v[2] + v[3] * v[3]); }
                        ss += shx(ss, 16, lane); ss += shx(ss, 32, lane);
                        if (fq == 0) SS[((ai * HALF + m * 16 + row0) * 2 + bj) * 4 + wc] = ss; }
            asm volatile("s_waitcnt lgkmcnt(0)" ::: "memory"); __builtin_amdgcn_s_barrier(); asm volatile("" ::: "memory");
            f32x4 gv[2][2];
#pragma unroll
            for (int bj = 0; bj < 2; ++bj)
#pragma unroll
                for (int n = 0; n < 2; ++n) gv[bj][n] = (type == 1) ? *(const f32x4*)(sgun + (col0 - 1024) + bj * HALF + 4 * n) : *(const f32x4*)((type == 2 ? qn : kn) + wc * 32 + 8 * fq + 4 * n);
#pragma unroll
            for (int ai = 0; ai < 2; ++ai)
#pragma unroll
                for (int m = 0; m < 4; ++m) { const int rt = ai * HALF + m * 16 + row0;
#pragma unroll
                    for (int bj = 0; bj < 2; ++bj) { const f32x4 p = *(const LAS f32x4*)(SS + (rt * 2 + bj) * 4);
                        const float rstd = rsqrtf(((p[0] + p[1]) + (p[2] + p[3])) * (1.0f / 128.0f) + NEPS);
#pragma unroll
                        for (int n = 0; n < 2; ++n) acc[ai][bj][m][n] = acc[ai][bj][m][n] * rstd * gv[bj][n]; }
                    if (type >= 2 && wc == 0) {
                        unsigned long long ro = (unsigned)(rt * 32 + 16 * (fq & 1)); asm volatile("" : "+v"(ro));
                        const float* rp = (rope + (size_t)u.pm * (BM * 32)) + ro;
                        const f32x4 c0 = *(const f32x4*)rp, c1 = *(const f32x4*)(rp + 4), c2 = *(const f32x4*)(rp + 8), c3 = *(const f32x4*)(rp + 12);
                        const float cs[8] = {c0[0], c0[2], c1[0], c1[2], c2[0], c2[2], c3[0], c3[2]}, sn[8] = {c0[1], c0[3], c1[1], c1[3], c2[1], c2[3], c3[1], c3[3]};
                        const float sg = (fq < 2) ? -1.0f : 1.0f;
#pragma unroll
                        for (int bj = 0; bj < 2; ++bj)
#pragma unroll
                            for (int n = 0; n < 2; ++n)
#pragma unroll
                                for (int j = 0; j < 4; ++j) { const float x = acc[ai][bj][m][n][j]; const float o = shx(x, 32, lane); acc[ai][bj][m][n][j] = x * cs[4 * n + j] + sg * o * sn[4 * n + j]; }
                    } }
        }
#pragma unroll
        for (int ai = 0; ai < 2; ++ai)
#pragma unroll
            for (int m = 0; m < 4; ++m) { bf16_t* rowp = (O + (size_t)u.pm * (BM * DIN) + u.pn * BM) + (unsigned)((ai * HALF + m * 16 + row0) * DIN + wc * 32 + 8 * fq);
#pragma unroll
                for (int bj = 0; bj < 2; ++bj) { const f32x4 v0 = acc[ai][bj][m][0], v1 = acc[ai][bj][m][1];
                    u32x4 w; w.x = cvt_pk_bf16(v0[0], v0[1]); w.y = cvt_pk_bf16(v0[2], v0[3]); w.z = cvt_pk_bf16(v1[0], v1[1]); w.w = cvt_pk_bf16(v1[2], v1[3]);
                    *(u32x4*)(rowp + bj * HALF) = w; } }
    }
};
struct EpiY8 {
    static constexpr bool PERM = true;
    unsigned char* O; const LAS int* seg;
    __device__ __forceinline__ void operator()(const f32x4 (&acc)[2][2][4][2], const Unit& u, int wr, int wc, int fr, int fq) const {
        constexpr float scale = YSC / (ASC_HID * WSC_D);
        const int rbase = seg[u.e] + u.pm * BM + wr * 64 + fr;
        const int col0 = u.pn * BM + wc * 32 + 8 * fq;
#pragma unroll
        for (int ai = 0; ai < 2; ++ai)
#pragma unroll
            for (int m = 0; m < 4; ++m) { unsigned char* rowp = O + (size_t)(rbase + ai * HALF + m * 16) * DM + col0;
#pragma unroll
                for (int bj = 0; bj < 2; ++bj) { const f32x4 v0 = acc[ai][bj][m][0] * scale, v1 = acc[ai][bj][m][1] * scale;
                    u32x2 w; w.x = pk4_fp8(v0[0], v0[1], v0[2], v0[3]); w.y = pk4_fp8(v1[0], v1[1], v1[2], v1[3]);
                    *(u32x2*)(rowp + bj * HALF) = w; } }
    }
};
struct EpiGateUp {
    static constexpr bool PERM = true;
    unsigned char* O; const LAS int* seg; int nostore;
    __device__ __forceinline__ void operator()(const f32x4 (&acc)[2][2][4][2], const Unit& u, int wr, int wc, int fr, int fq) const {
        if (nostore == 1) return;
        const int rbase = seg[u.e] + u.pm * BM + wr * 64 + fr;
        const int col0 = u.pn * HALF + wc * 32 + 8 * fq;
        constexpr float sg = 1.0f / (ASC_H * WSC_GU);
#pragma unroll
        for (int ai = 0; ai < 2; ++ai)
#pragma unroll
            for (int m = 0; m < 4; ++m) { unsigned char* rowp = O + (size_t)(rbase + ai * HALF + m * 16) * 512 + col0;
                float h[8];
#pragma unroll
                for (int n = 0; n < 2; ++n)
#pragma unroll
                    for (int j = 0; j < 4; ++j) h[4 * n + j] = silu1(acc[ai][0][m][n][j] * sg) * (acc[ai][1][m][n][j] * (sg * ASC_HID));
                u32x2 w; w.x = pk4_fp8(h[0], h[1], h[2], h[3]); w.y = pk4_fp8(h[4], h[5], h[6], h[7]);
                if (nostore == 2) { asm volatile("" :: "v"(w.x), "v"(w.y)); } else *(u32x2*)rowp = w; }
    }
};
struct EpiDelta {
    static constexpr bool PERM = true;
    bf16_t* O; const float* g; float scale;
    __device__ __forceinline__ void operator()(const f32x4 (&acc)[2][2][4][2], const Unit& u, int wr, int wc, int fr, int fq) const {
        const int row0 = u.pm * BM + wr * 64 + fr, col0 = u.pn * BM + wc * 32 + 8 * fq;
        f32x4 gv[2][2];
#pragma unroll
        for (int bj = 0; bj < 2; ++bj)
#pragma unroll
            for (int n = 0; n < 2; ++n) gv[bj][n] = *(const f32x4*)(g + col0 + bj * HALF + 4 * n) * scale;
#pragma unroll
        for (int ai = 0; ai < 2; ++ai)
#pragma unroll
            for (int m = 0; m < 4; ++m) { bf16_t* rowp = O + (size_t)(row0 + ai * HALF + m * 16) * DM + col0;
#pragma unroll
                for (int bj = 0; bj < 2; ++bj) { const f32x4 v0 = acc[ai][bj][m][0] * gv[bj][0], v1 = acc[ai][bj][m][1] * gv[bj][1];
                    u32x4 w; w.x = cvt_pk_bf16(v0[0], v0[1]); w.y = cvt_pk_bf16(v0[2], v0[3]); w.z = cvt_pk_bf16(v1[0], v1[1]); w.w = cvt_pk_bf16(v1[2], v1[3]);
                    *(u32x4*)(rowp + bj * HALF) = w; } }
    }
};
}

struct Args { const float* in[23]; float* out; unsigned char* ws; int ph_lo, ph_hi; };
enum { I_X = 0, I_C, I_ADAW, I_ADAB, I_MIXN, I_WIN, I_SGUN, I_SGUW, I_SGUB, I_QN, I_KN, I_ONS, I_ONA, I_WOUT, I_FFNN, I_RW, I_RB, I_EG, I_EU, I_ED, I_SG, I_SU, I_SD };

__device__ __forceinline__ void transpose_item(const float* W, int K, int N, bf16_t* WT, int kb, int nb, int dst_row0, LAS float* scr, int lane) {
    const int k0 = 64 * kb, n0 = 32 * nb;
#pragma unroll 8
    for (int i = 0; i < 32; ++i) { const int kk = 2 * i + (lane >> 5); scr[kk * 33 + (lane & 31)] = __builtin_nontemporal_load(&W[(size_t)(k0 + kk) * N + n0 + (lane & 31)]); }
    asm volatile("s_waitcnt lgkmcnt(0)" ::: "memory");
    const int c = lane & 7;
#pragma unroll
    for (int j = 0; j < 4; ++j) { const int n = (lane >> 3) + 8 * j; const LAS float* s = scr + (8 * c) * 33 + n;
        u32x4 o; o.x = cvt_pk_bf16(s[0 * 33], s[1 * 33]); o.y = cvt_pk_bf16(s[2 * 33], s[3 * 33]); o.z = cvt_pk_bf16(s[4 * 33], s[5 * 33]); o.w = cvt_pk_bf16(s[6 * 33], s[7 * 33]);
        *(u32x4*)(WT + (size_t)(dst_row0 + n) * K + k0 + 8 * c) = o; }
    asm volatile("s_waitcnt lgkmcnt(0)" ::: "memory");
}

__device__ __forceinline__ void transpose_item8(const float* W, int K, int N, unsigned char* WT, int kb, int nb, int dst_row0, float scale, LAS float* scr, int lane) {
    const int k0 = 128 * kb, n0 = 32 * nb;
#pragma unroll 8
    for (int i = 0; i < 64; ++i) { const int kk = 2 * i + (lane >> 5); scr[kk * 33 + (lane & 31)] = __builtin_nontemporal_load(&W[(size_t)(k0 + kk) * N + n0 + (lane & 31)]); }
    asm volatile("s_waitcnt lgkmcnt(0)" ::: "memory");
    const int c = lane & 7;
#pragma unroll
    for (int j = 0; j < 4; ++j) { const int n = (lane >> 3) + 8 * j; const LAS float* s = scr + (16 * c) * 33 + n;
        u32x4 o; o.x = pk4_fp8(s[0 * 33] * scale, s[1 * 33] * scale, s[2 * 33] * scale, s[3 * 33] * scale); o.y = pk4_fp8(s[4 * 33] * scale, s[5 * 33] * scale, s[6 * 33] * scale, s[7 * 33] * scale);
        o.z = pk4_fp8(s[8 * 33] * scale, s[9 * 33] * scale, s[10 * 33] * scale, s[11 * 33] * scale); o.w = pk4_fp8(s[12 * 33] * scale, s[13 * 33] * scale, s[14 * 33] * scale, s[15 * 33] * scale);
        *(u32x4*)(WT + (size_t)(dst_row0 + n) * K + k0 + 16 * c) = o; }
    asm volatile("s_waitcnt lgkmcnt(0)" ::: "memory");
}

__device__ __forceinline__ void phase_prologue(const Args& a, LAS unsigned char* lds, int tid, int wave, int lane) {
    const int G = gridDim.x, gw = blockIdx.x * NWAVES + wave, NGW = G * NWAVES;
    const size_t gt = (size_t)blockIdx.x * NTHREADS + tid, NGT = (size_t)G * NTHREADS;
    unsigned char* ws = a.ws;
    {
        float* modp = (float*)(ws + WS_MODP);
        for (int u = gw; u < 2 * 16 * 48; u += NGW) {
            const int l = u / 768, r = u % 768, kc = r / 48, cc = r % 48;
            const float* w = a.in[I_ADAW] + ((size_t)l * DM + kc * 128) * 12288 + cc * 256 + 4 * lane;
            const float* cv = a.in[I_C] + kc * 128;
            f32x4 s = {0.f, 0.f, 0.f, 0.f};
#pragma unroll 8
            for (int k = 0; k < 128; ++k) { const float cvk = cv[k]; const float cd = cvk / (1.0f + __expf(-cvk)); const f32x4 wv = __builtin_nontemporal_load((const f32x4*)(w + (size_t)k * 12288)); s += wv * cd; }
            *(f32x4*)(modp + ((size_t)kc * 2 + l) * 12288 + cc * 256 + 4 * lane) = s;
        }
    }
    {
        float* rope = (float*)(ws + WS_ROPE);
        for (size_t i = gt; i < (size_t)SEQ * 16; i += NGT) {
            const int pos = (int)(i >> 4), f = (int)(i & 15);
            const float inv = (float)exp2(-(double)f * (1.0 / 16.0) * 18.931568569324174);
            const float ang = (float)pos * inv;
            double rev = (double)ang * 0.15915494309189535; rev -= rint(rev);
            rope[2 * i] = __builtin_amdgcn_cosf((float)rev); rope[2 * i + 1] = __builtin_amdgcn_sinf((float)rev);
        }
    }
    {
        bf16_t* sg = (bf16_t*)(ws + WS_SGUW);
        for (size_t i = gt; i < (size_t)2 * 8 * 128 * 128; i += NGT) { const int jj = (int)(i & 127), ii = (int)((i >> 7) & 127); const float v = a.in[I_SGUW][i];
            sg[(i & ~(size_t)127) + (size_t)((jj & ~31) + 8 * (jj & 3) + ((jj >> 2) & 7))] = (bf16_t)(cvt_pk_bf16(jj <= ii ? v : 0.f, 0.f) & 0xffffu); }
        bf16_t* rt = (bf16_t*)(ws + WS_RT);
        for (size_t i = gt; i < (size_t)2 * 2048 * 64; i += NGT) { const int l = (int)(i >> 17), r = (int)(i & 131071), k = r >> 6, e = r & 63; const float v = a.in[I_RW][i];
            const unsigned hi = cvt_pk_bf16(v, 0.f) & 0xffffu; const float lo = v - __uint_as_float(hi << 16);
            const int fo = ((((k >> 5) * 4 + (e >> 4)) * 64 + ((k >> 3) & 3) * 16 + (e & 15)) << 3) + (k & 7);
            rt[(size_t)l * 262144 + fo] = (bf16_t)hi; rt[(size_t)l * 262144 + 131072 + fo] = (bf16_t)(cvt_pk_bf16(lo, 0.f) & 0xffffu); }
    }
    {
        LAS float* scr = (LAS float*)(lds + wave * 17408);
#if WIN_FP8
        constexpr int I_WIN_ITEMS = 16 * 160;
#else
        constexpr int I_WIN_ITEMS = 32 * 160;
#endif
#if WOUT_FP8
        constexpr int I_WOUT_ITEMS = 16 * 64;
#else
        constexpr int I_WOUT_ITEMS = 32 * 64;
#endif
        constexpr int PER_LAYER = I_WIN_ITEMS + I_WOUT_ITEMS + 65 * 768;
        for (int it = gw; it < 2 * PER_LAYER; it += NGW) {
            const int l = it / PER_LAYER; int r = it % PER_LAYER;
            unsigned char* wl = ws + WS_W + (size_t)l * W_LAYER;
            if (r < I_WIN_ITEMS) {
#if WIN_FP8
                transpose_item8(a.in[I_WIN] + (size_t)l * DM * DIN, DM, DIN, wl + W_IN, r / 160, r % 160, 32 * (r % 160), WSC_GU, scr, lane);
#else
                transpose_item(a.in[I_WIN] + (size_t)l * DM * DIN, DM, DIN, (bf16_t*)(wl + W_IN), r / 160, r % 160, 32 * (r % 160), scr, lane);
#endif
                continue; }
            r -= I_WIN_ITEMS;
            if (r < I_WOUT_ITEMS) {
#if WOUT_FP8
                transpose_item8(a.in[I_WOUT] + (size_t)l * DM * DM, DM, DM, wl + W_OUT, r / 64, r % 64, 32 * (r % 64), WSC_GU, scr, lane);
#else
                transpose_item(a.in[I_WOUT] + (size_t)l * DM * DM, DM, DM, (bf16_t*)(wl + W_OUT), r / 64, r % 64, 32 * (r % 64), scr, lane);
#endif
                continue; }
            r -= I_WOUT_ITEMS;
            const int e = r / 768, q = r % 768, which = q / 256, s = q % 256;
            if (which < 2) {
                const float* src = (e < 64) ? a.in[which == 0 ? I_EG : I_EU] + ((size_t)l * 64 + e) * (size_t)DM * 512 : a.in[which == 0 ? I_SG : I_SU] + (size_t)l * DM * 512;
                const int kb = s / 16, nb = s % 16, n0 = 32 * nb;
                transpose_item8(src, DM, 512, wl + W_GU + (size_t)e * 2 * MiB, kb, nb, 256 * (n0 >> 7) + 128 * which + (n0 & 127), WSC_GU, scr, lane);
            } else {
                const float* src = (e < 64) ? a.in[I_ED] + ((size_t)l * 64 + e) * (size_t)512 * DM : a.in[I_SD] + (size_t)l * 512 * DM;
                const int kb = s / 64, nb = s % 64;
                transpose_item8(src, 512, DM, wl + W_D + (size_t)e * 1 * MiB, kb, nb, 32 * nb, WSC_D, scr, lane);
            }
        }
    }
}

__device__ __forceinline__ void phase_modreduce(const Args& a, int tid) {
    const float* modp = (const float*)(a.ws + WS_MODP); float* mod = (float*)(a.ws + WS_CTL) + CW_MOD;
    for (int i = blockIdx.x * NTHREADS + tid; i < 2 * 12288; i += gridDim.x * NTHREADS) { float s = a.in[I_ADAB][i];
#pragma unroll
        for (int kc = 0; kc < 16; ++kc) s += modp[(size_t)kc * 24576 + i];
        mod[i] = s; }
}

__device__ __forceinline__ void load_row(const float* row, int lane, f32x4 (&v)[8]) {
#pragma unroll
    for (int j = 0; j < 4; ++j) { const f32x4* p = (const f32x4*)(row + 8 * (64 * j + lane)); v[2 * j] = p[0]; v[2 * j + 1] = p[1]; }
}
__device__ __forceinline__ void add_row_bf16(const bf16_t* row, int lane, f32x4 (&v)[8]) {
#pragma unroll
    for (int j = 0; j < 4; ++j) { float t[8]; unpack8(*(const u32x4*)(row + 8 * (64 * j + lane)), t);
        v[2 * j] += (f32x4){t[0], t[1], t[2], t[3]}; v[2 * j + 1] += (f32x4){t[4], t[5], t[6], t[7]}; }
}
__device__ __forceinline__ float sumsq8(const f32x4 (&v)[8]) { float s = 0.f;
#pragma unroll
    for (int j = 0; j < 8; ++j) s += (v[j][0] * v[j][0] + v[j][1] * v[j][1]) + (v[j][2] * v[j][2] + v[j][3] * v[j][3]);
    return s; }
__device__ __forceinline__ void load_mod_vecs(const float* gain, const float* sc, const float* sh, int lane, f32x4 (&ga)[8], f32x4 (&gb)[8]) {
    f32x4 g[8], s[8]; load_row(gain, lane, g); load_row(sc, lane, s); load_row(sh, lane, gb);
#pragma unroll
    for (int j = 0; j < 8; ++j) ga[j] = g[j] * (s[j] + 1.0f);
}
__device__ __forceinline__ void store_row_bf16(bf16_t* row, int lane, const f32x4 (&h)[8]) {
#pragma unroll
    for (int j = 0; j < 4; ++j) { u32x4 w; w.x = cvt_pk_bf16(h[2 * j][0], h[2 * j][1]); w.y = cvt_pk_bf16(h[2 * j][2], h[2 * j][3]); w.z = cvt_pk_bf16(h[2 * j + 1][0], h[2 * j + 1][1]); w.w = cvt_pk_bf16(h[2 * j + 1][2], h[2 * j + 1][3]);
        *(u32x4*)(row + 8 * (64 * j + lane)) = w; }
}

__device__ __forceinline__ void store_row_fp8(unsigned char* row, int lane, const f32x4 (&h)[8], float sc) {
#pragma unroll
    for (int j = 0; j < 4; ++j) { u32x2 w; w.x = pk4_fp8(h[2 * j][0] * sc, h[2 * j][1] * sc, h[2 * j][2] * sc, h[2 * j][3] * sc); w.y = pk4_fp8(h[2 * j + 1][0] * sc, h[2 * j + 1][1] * sc, h[2 * j + 1][2] * sc, h[2 * j + 1][3] * sc);
        *(u32x2*)(row + 8 * (64 * j + lane)) = w; }
}

__device__ __forceinline__ void phase_norm1(const Args& a, int l, const float* xin, int wave, int lane) {
    const int gw = blockIdx.x * NWAVES + wave, NGW = gridDim.x * NWAVES;
    const float* mod = (const float*)(a.ws + WS_CTL) + CW_MOD + l * 12288;
    bf16_t* H = (bf16_t*)(a.ws + WS_H);
    f32x4 ga[8], gb[8]; load_mod_vecs(a.in[I_MIXN] + l * DM, mod + 2048, mod + 0, lane, ga, gb);
    for (int m = gw; m < SEQ; m += 2 * NGW) {
        const int m2 = (m + NGW < SEQ) ? m + NGW : m;
        f32x4 v[8], u[8]; load_row(xin + (size_t)m * DM, lane, v); load_row(xin + (size_t)m2 * DM, lane, u);
        const float rstd = rsqrtf(wave_sum(sumsq8(v), lane) * (1.0f / DM) + NEPS), rstd2 = rsqrtf(wave_sum(sumsq8(u), lane) * (1.0f / DM) + NEPS);
#pragma unroll
        for (int j = 0; j < 8; ++j) { v[j] = v[j] * rstd * ga[j] + gb[j]; u[j] = u[j] * rstd2 * ga[j] + gb[j]; }
#if WIN_FP8
        store_row_fp8((unsigned char*)H + (size_t)m * DM, lane, v, ASC_H); store_row_fp8((unsigned char*)H + (size_t)m2 * DM, lane, u, ASC_H);
#else
        store_row_bf16(H + (size_t)m * DM, lane, v); store_row_bf16(H + (size_t)m2 * DM, lane, u);
#endif
    }
}

__device__ __forceinline__ void phase_post(const Args& a, int l, int wave, int lane, bool dummy) {
    const int gw = blockIdx.x * NWAVES + wave, NGW = gridDim.x * NWAVES;
    bf16_t* P = (bf16_t*)(a.ws + WS_PROJ);
    bf16_t* PD = dummy ? (bf16_t*)(a.ws + WS_DUMMY) : P;
    const float* rope = (const float*)(a.ws + WS_ROPE);
    const int c0 = 16 * lane;
    const int dim0 = (lane & 7) * 16;
    float gs[16], gq[16], gk[16];
#pragma unroll
    for (int j = 0; j < 16; ++j) { gs[j] = a.in[I_SGUN][l * 1024 + c0 + j]; gq[j] = a.in[I_QN][l * 128 + dim0 + j]; gk[j] = a.in[I_KN][l * 128 + dim0 + j]; }
    for (int m = gw; m < SEQ; m += NGW) {
        const bf16_t* row = P + (size_t)m * DIN; bf16_t* drow = PD + (size_t)m * DIN;
        { u32x4 w0 = *(const u32x4*)(row + c0), w1 = *(const u32x4*)(row + c0 + 8); float f[16]; { float t[8]; unpack8(w0, t);
#pragma unroll
              for (int j = 0; j < 8; ++j) f[j] = t[j]; unpack8(w1, t);
#pragma unroll
              for (int j = 0; j < 8; ++j) f[8 + j] = t[j]; }
#pragma unroll
          for (int j = 0; j < 16; ++j) f[j] = gelu1(f[j]);
          float t0[8], t1[8];
#pragma unroll
          for (int j = 0; j < 8; ++j) { t0[j] = f[j]; t1[j] = f[8 + j]; }
          *(u32x4*)(drow + c0) = pack8(t0); *(u32x4*)(drow + c0 + 8) = pack8(t1); }
        { u32x4 w0 = *(const u32x4*)(row + 1024 + c0), w1 = *(const u32x4*)(row + 1024 + c0 + 8); float f[16]; { float t[8]; unpack8(w0, t);
#pragma unroll
              for (int j = 0; j < 8; ++j) f[j] = t[j]; unpack8(w1, t);
#pragma unroll
              for (int j = 0; j < 8; ++j) f[8 + j] = t[j]; }
          float ss = 0.f;
#pragma unroll
          for (int j = 0; j < 16; ++j) { f[j] = gelu1(f[j]); ss += f[j] * f[j]; }
          ss += shx(ss, 1, lane); ss += shx(ss, 2, lane); ss += shx(ss, 4, lane);
          const float rstd = rsqrtf(ss * (1.0f / 128.0f) + NEPS);
          float t0[8], t1[8];
#pragma unroll
          for (int j = 0; j < 8; ++j) { t0[j] = f[j] * rstd * gs[j]; t1[j] = f[8 + j] * rstd * gs[8 + j]; }
          *(u32x4*)(drow + 1024 + c0) = pack8(t0); *(u32x4*)(drow + 1024 + c0 + 8) = pack8(t1); }
#pragma unroll
        for (int qk = 0; qk < 2; ++qk) {
            const bf16_t* p = row + 2048 + qk * 1024 + c0; bf16_t* dp = drow + 2048 + qk * 1024 + c0;
            u32x4 w0 = *(const u32x4*)p, w1 = *(const u32x4*)(p + 8); float f[16]; { float t[8]; unpack8(w0, t);
#pragma unroll
              for (int j = 0; j < 8; ++j) f[j] = t[j]; unpack8(w1, t);
#pragma unroll
              for (int j = 0; j < 8; ++j) f[8 + j] = t[j]; }
            float ss = 0.f;
#pragma unroll
            for (int j = 0; j < 16; ++j) ss += f[j] * f[j];
            ss += shx(ss, 1, lane); ss += shx(ss, 2, lane); ss += shx(ss, 4, lane);
            const float rstd = rsqrtf(ss * (1.0f / 128.0f) + NEPS);
#pragma unroll
            for (int j = 0; j < 16; ++j) f[j] = f[j] * rstd * (qk == 0 ? gq[j] : gk[j]);
            const int sub = lane & 7;
#pragma unroll
            for (int j = 0; j < 16; ++j) { const float other = shx(f[j], 1, lane);
                if (sub < 2) { const float cs = rope[((size_t)m * 16 + j) * 2], sn = rope[((size_t)m * 16 + j) * 2 + 1];
                    f[j] = (sub == 0) ? (f[j] * cs - other * sn) : (f[j] * cs + other * sn); } }
            float t0[8], t1[8];
#pragma unroll
            for (int j = 0; j < 8; ++j) { t0[j] = f[j]; t1[j] = f[8 + j]; }
            *(u32x4*)dp = pack8(t0); *(u32x4*)(dp + 8) = pack8(t1);
        }
    }
}

constexpr int TSTR = 288;
__device__ __forceinline__ void sgu_fetch(const Args& a, int uid, int tid, u32x4 (&pu)[4], u32x4 (&pv)[4]) {
    const int n = uid >> 3, g = uid & 7;
    const bf16_t* P = (const bf16_t*)(a.ws + WS_PROJ);
#pragma unroll
    for (int it = 0; it < 4; ++it) { const int c = tid + 512 * it, row = c >> 4, ch = c & 15;
        const bf16_t* src = P + (size_t)(128 * n + row) * DIN + 128 * g + 8 * ch;
        pu[it] = *(const u32x4*)src; pv[it] = *(const u32x4*)(src + 1024); }
}
__device__ __forceinline__ void sgu_unit(const Args& a, int l, LAS unsigned char* lds, int uid, int nuid, int tid, int wid, int lane, u32x4 (&pu)[4], u32x4 (&pv)[4]) {
    const int n = uid >> 3, g = uid & 7;
    bf16_t* YM = (bf16_t*)(a.ws + WS_YMIX);
    LAS unsigned char* LU = lds; LAS unsigned char* LV = lds + 128 * TSTR;
#pragma unroll
    for (int it = 0; it < 4; ++it) { const int c = tid + 512 * it, row = c >> 4, ch = c & 15;
        *(LAS u32x4*)(LU + row * TSTR + ch * 16) = pu[it];
        *(LAS u32x4*)(LV + row * TSTR + ch * 16) = pv[it]; }
    __syncthreads();
    if (nuid < 1024) sgu_fetch(a, nuid, tid, pu, pv);
    const int fr = lane & 15, kg = lane >> 4, q4 = fr >> 2, p4 = lane & 3;
    const bf16_t* W = (const bf16_t*)(a.ws + WS_SGUW) + ((size_t)(l * 8 + g) * 128 + 16 * wid + fr) * 128 + 8 * kg;
    bf16x8 af[4];
#pragma unroll
    for (int ks = 0; ks < 4; ++ks) af[ks] = *(const bf16x8*)(W + 32 * ks);
    f32x4 acc[8];
#pragma unroll
    for (int ct = 0; ct < 8; ++ct) { acc[ct] = (f32x4){0.f, 0.f, 0.f, 0.f};
#pragma unroll
        for (int ks = 0; ks < 4; ++ks) {
            unsigned vba = (unsigned)(size_t)(LV + (32 * ks + 8 * kg + q4) * TSTR + (16 * ct + 4 * p4) * 2); asm volatile("" : "+v"(vba));
            const LAS unsigned char* vb = (const LAS unsigned char*)(size_t)vba;
#if DIAG_NOTR
            bf16x8 bfr; (void)vb;
#pragma unroll
            for (int j = 0; j < 8; ++j) bfr[j] = (short)*(const LAS bf16_t*)(LV + (32 * ks + 4 * j + kg) * TSTR + (16 * ct + fr) * 2);
#else
            const bf16x8 bfr = cat4(lds_tr(vb), lds_tr(vb + 4 * TSTR));
#endif
#if !DIAG_NOTR
            asm volatile("s_waitcnt lgkmcnt(0)" ::: "memory");
#endif
            acc[ct] = __builtin_amdgcn_mfma_f32_16x16x32_bf16(af[ks], bfr, acc[ct], 0, 0, 0); } }
    float bsv[4], ss[4] = {0.f, 0.f, 0.f, 0.f};
#pragma unroll
    for (int r = 0; r < 4; ++r) bsv[r] = a.in[I_SGUB][(l * 8 + g) * 128 + 16 * wid + 4 * kg + r];
#pragma unroll
    for (int ct = 0; ct < 8; ++ct)
#pragma unroll
        for (int r = 0; r < 4; ++r) { const int i = 16 * wid + 4 * kg + r, c = 16 * ct + fr;
            const float u = bf2f(*(const LAS bf16_t*)(LU + i * TSTR + c * 2));
            const float y = u * (acc[ct][r] + bsv[r]); acc[ct][r] = y; ss[r] += y * y; }
#pragma unroll
    for (int r = 0; r < 4; ++r) { float s = ss[r]; s += shx(s, 1, lane); s += shx(s, 2, lane); s += shx(s, 4, lane); s += shx(s, 8, lane); ss[r] = rsqrtf(s * (1.0f / 128.0f) + NEPS); }
#pragma unroll
    for (int ct = 0; ct < 8; ++ct) { const int c = 16 * ct + fr; const float go = a.in[I_ONS][l * 1024 + 128 * g + c];
#pragma unroll
        for (int r = 0; r < 4; ++r) { const int i = 16 * wid + 4 * kg + r;
#if WOUT_FP8
            ((unsigned char*)YM)[(size_t)(128 * n + i) * DM + 128 * g + c] = (unsigned char)(pk4_fp8(acc[ct][r] * ss[r] * go * ASC_H, 0.f, 0.f, 0.f) & 0xffu);
#else
            YM[(size_t)(128 * n + i) * DM + 128 * g + c] = (bf16_t)(cvt_pk_bf16(acc[ct][r] * ss[r] * go, 0.f) & 0xffffu);
#endif
            } }
    __syncthreads();
}

__device__ __forceinline__ void glds16(const void* sbase, unsigned voff, unsigned ldsaddr) {
    unsigned keep; asm volatile("s_mov_b32 %0, m0\n\ts_mov_b32 m0, %3\n\ts_nop 0\n\tglobal_load_lds_dwordx4 %1, %2\n\ts_mov_b32 m0, %0" : "=&s"(keep) : "v"(voff), "s"(sbase), "s"(ldsaddr) : "memory");
}
struct AttnUnitDesc { int p, h, dsh, n, qbase, kbase; };
__device__ __forceinline__ AttnUnitDesc attn_desc(int uid) {
    AttnUnitDesc d; d.p = uid >> 10; const int rem = uid & 1023; d.h = rem >> 7; const int rn = rem & 127;
    d.dsh = 2 * d.p; const int nbsh = 7 - d.dsh; const int r = rn >> nbsh; d.n = rn & ((1 << nbsh) - 1);
    d.qbase = r + ((128 * d.n) << d.dsh); d.kbase = d.qbase - (128 << d.dsh); return d;
}
__device__ __forceinline__ void attn_issue(const bf16_t* P, const AttnUnitDesc& d, int which, unsigned ldsbase, int wid, int lane) {
    const int colbase = (which == 0 ? 3072 : 4096) + d.h * 128;
#pragma unroll
    for (int j = 0; j < 8; ++j) { const int piece = 8 * wid + j, row = 4 * piece + (lane >> 4), c = lane & 15;
        const int kj = (d.n == 0 && row < 128) ? row + 128 : row;
        const int pos = d.kbase + (kj << d.dsh);
        const unsigned voff = (unsigned)pos * (unsigned)(DIN * 2) + (unsigned)(colbase * 2) + (unsigned)((c ^ (which == 0 ? (row & 15) : 2 * (row & 7))) * 16);
        glds16(P, voff, ldsbase + (unsigned)(which * 65536 + piece * 1024)); }
}
__device__ __forceinline__ void attn_units(const Args& a, LAS unsigned char* lds, int first_uid, int tid, int wid, int lane) {
    const bf16_t* P = (const bf16_t*)(a.ws + WS_PROJ);
    bf16_t* ATT = (bf16_t*)(a.ws + WS_ATT);
    float* LSE = (float*)(a.ws + WS_LSE);
    const unsigned ldsbase = (unsigned)(size_t)lds;
    const int fr = lane & 15, kg = lane >> 4, q4 = fr >> 2, p4 = lane & 3;
    const int qi = 16 * wid + fr;
    int uid = first_uid;
    if (uid >= 3072) return;
    AttnUnitDesc d = attn_desc(uid);
#if ATT_PIPE
    attn_issue(P, d, 0, ldsbase, wid, lane); attn_issue(P, d, 1, ldsbase, wid, lane);
#endif
    bf16x8 qf[4];
    { const bf16_t* qrow = P + (size_t)(d.qbase + (qi << d.dsh)) * DIN + 2048 + d.h * 128 + 8 * kg;
#pragma unroll
      for (int ks = 0; ks < 4; ++ks) qf[ks] = *(const bf16x8*)(qrow + 32 * ks); }
    bool first = true;
    u32x2 pw[8]; bf16_t* porow = ATT; float* plsep = LSE; float plse = 0.f;
#pragma unroll
    for (int dt = 0; dt < 8; ++dt) pw[dt] = (u32x2){0u, 0u};
    for (;;) {
        const int nuid = uid + (int)gridDim.x; const bool has_next = nuid < 3072;
        AttnUnitDesc dn = d; if (has_next) dn = attn_desc(nuid);
#if !ATT_PIPE
        __syncthreads();
#if ATT_CLEAR
        for (int i = tid; i < 8192; i += NTHREADS) *(LAS u32x4*)(lds + 16 * i) = (u32x4){0u, 0u, 0u, 0u};
        asm volatile("s_waitcnt lgkmcnt(0)" ::: "memory"); __syncthreads();
#endif
#if ATT_VOLD
#pragma unroll
        for (int it = 0; it < 8; ++it) { const int c = tid + 512 * it, row = c >> 4, ch = c & 15;
            const int kj = (d.n == 0 && row < 128) ? row + 128 : row;
            const int pos = d.kbase + (kj << d.dsh);
            *(LAS u32x4*)(lds + row * TSTR + ch * 16) = *(const u32x4*)(P + (size_t)pos * DIN + 4096 + d.h * 128 + 8 * ch); }
#else
        attn_issue(P, d, 0, ldsbase, wid, lane); attn_issue(P, d, 1, ldsbase, wid, lane);
#endif
#endif
        if (first) asm volatile("s_waitcnt vmcnt(0)" ::: "memory"); else asm volatile("s_waitcnt vmcnt(8)" ::: "memory");
        __builtin_amdgcn_s_barrier(); asm volatile("" ::: "memory");
        if (!first) {
#pragma unroll
            for (int dt = 0; dt < 8; ++dt) *(u32x2*)(porow + 16 * dt) = pw[dt];
            if (kg == 0) *plsep = plse; }
        first = false;
        f32x4 s[10]; int mism = 0;
#pragma unroll
        for (int i = 0; i < 10; ++i) { const int T = (wid + i) < 15 ? (wid + i) : 15; const int row = 16 * T + fr;
            const LAS unsigned char* kb = lds + row * 256; const int sw = fr;
            f32x4 c4 = {0.f, 0.f, 0.f, 0.f};
#if ATT_KGLOBAL
            { const int kj0 = (d.n == 0 && row < 128) ? row + 128 : row; const bf16_t* krow = P + (size_t)(d.kbase + (kj0 << d.dsh)) * DIN + 3072 + d.h * 128 + 8 * kg;
#pragma unroll
              for (int ks = 0; ks < 4; ++ks) { const bf16x8 kgl = *(const bf16x8*)(krow + 32 * ks);
                  if (i == ATT_CHK_TILE) { const bf16x8 kld = *(const LAS bf16x8*)(kb + (((4 * ks + kg) ^ sw) * 16));
                      typedef int v4i __attribute__((ext_vector_type(4))); const v4i xa = __builtin_bit_cast(v4i, kgl), xb = __builtin_bit_cast(v4i, kld);
                      mism |= (xa[0] ^ xb[0]) | (xa[1] ^ xb[1]) | (xa[2] ^ xb[2]) | (xa[3] ^ xb[3]); }
                  c4 = __builtin_amdgcn_mfma_f32_16x16x32_bf16(kgl, qf[ks], c4, 0, 0, 0); } }
#else
            if (i < 9) {
#pragma unroll
                for (int ks = 0; ks < 4; ++ks) c4 = __builtin_amdgcn_mfma_f32_16x16x32_bf16(*(const LAS bf16x8*)(kb + (((4 * ks + kg) ^ sw) * 16)), qf[ks], c4, 0, 0, 0); }
#endif
            s[i] = c4; }
        asm volatile("s_waitcnt vmcnt(0) lgkmcnt(0)" ::: "memory"); __builtin_amdgcn_s_barrier(); asm volatile("" ::: "memory");
        if (has_next) {
#if ATT_PIPE
            attn_issue(P, dn, 0, ldsbase, wid, lane);
#endif
            const bf16_t* qrow = P + (size_t)(dn.qbase + (qi << dn.dsh)) * DIN + 2048 + dn.h * 128 + 8 * kg;
#pragma unroll
            for (int ks = 0; ks < 4; ++ks) qf[ks] = *(const bf16x8*)(qrow + 32 * ks); }
#if ATT_KGLOBAL
        if (__builtin_amdgcn_ballot_w64(mism != 0) != 0ull) { const unsigned long long t0 = __builtin_amdgcn_s_memrealtime(); while (__builtin_amdgcn_s_memrealtime() - t0 < 5000ull) __builtin_amdgcn_s_sleep(8); }
#endif
        const float sc = 0.08838834764831845f * 1.4426950408889634f;
        float mx = -INFINITY;
        int qim = qi; asm volatile("" : "+v"(qim));
#pragma unroll
        for (int i = 0; i < 10; ++i)
#pragma unroll
            for (int rg = 0; rg < 4; ++rg) { const int kj = 16 * (wid + i) + 4 * kg + rg, dist = qim + 128 - kj;
                const bool inwin = (i == 0) ? (dist <= 128) : (i == 8) ? (dist >= 0) : (i < 9);
                const bool valid = (wid + i <= 15) && inwin && (d.n > 0 || wid + i >= 8);
                const float v = valid ? s[i][rg] * sc : -INFINITY; s[i][rg] = v; mx = fmaxf(mx, v); }
        mx = fmaxf(mx, shx(mx, 16, lane)); mx = fmaxf(mx, shx(mx, 32, lane));
        float sum = 0.f;
#pragma unroll
        for (int i = 0; i < 10; ++i)
#pragma unroll
            for (int rg = 0; rg < 4; ++rg) { const float e = __builtin_amdgcn_exp2f(s[i][rg] - mx); s[i][rg] = e; sum += e; }
        sum += shx(sum, 16, lane); sum += shx(sum, 32, lane);
        bf16x8 pf[5];
#pragma unroll
        for (int ks = 0; ks < 5; ++ks) { u32x4 w; w.x = cvt_pk_bf16(s[2 * ks][0], s[2 * ks][1]); w.y = cvt_pk_bf16(s[2 * ks][2], s[2 * ks][3]); w.z = cvt_pk_bf16(s[2 * ks + 1][0], s[2 * ks + 1][1]); w.w = cvt_pk_bf16(s[2 * ks + 1][2], s[2 * ks + 1][3]);
            pf[ks] = __builtin_bit_cast(bf16x8, w); }
        f32x4 o[8];
#pragma unroll
        for (int dt = 0; dt < 8; ++dt) o[dt] = (f32x4){0.f, 0.f, 0.f, 0.f};
        const int swv = 2 * (4 * (kg & 1) + q4);
#pragma unroll
        for (int ks = 0; ks < 5; ++ks) { const int T0 = (wid + 2 * ks) < 15 ? (wid + 2 * ks) : 15, T1 = (wid + 2 * ks + 1) < 15 ? (wid + 2 * ks + 1) : 15;
#if ATT_VOLD
            const LAS unsigned char* v0 = lds + (16 * T0 + 4 * kg + q4) * TSTR + 8 * p4;
            const LAS unsigned char* v1 = lds + (16 * T1 + 4 * kg + q4) * TSTR + 8 * p4; (void)swv;
#else
            const LAS unsigned char* v0 = lds + 65536 + (16 * T0 + 4 * kg + q4) * 256 + 8 * (p4 & 1);
            const LAS unsigned char* v1 = lds + 65536 + (16 * T1 + 4 * kg + q4) * 256 + 8 * (p4 & 1);
#endif
            { unsigned a0 = (unsigned)(size_t)v0, a1 = (unsigned)(size_t)v1; asm volatile("" : "+v"(a0), "+v"(a1)); v0 = (const LAS unsigned char*)(size_t)a0; v1 = (const LAS unsigned char*)(size_t)a1; }
#pragma unroll
            for (int dt = 0; dt < 8; ++dt) {
#if ATT_VOLD
                const int co = 32 * dt;
#else
                const int co = (((2 * dt) ^ swv) + (p4 >> 1)) * 16;
#endif
                const bf16x8 vf = cat4(lds_tr(v0 + co), lds_tr(v1 + co));
                asm volatile("s_waitcnt lgkmcnt(0)" ::: "memory");
                o[dt] = __builtin_amdgcn_mfma_f32_16x16x32_bf16(vf, pf[ks], o[dt], 0, 0, 0); } }
        asm volatile("s_waitcnt lgkmcnt(0)" ::: "memory"); __builtin_amdgcn_s_barrier(); asm volatile("" ::: "memory");
        if (has_next) attn_issue(P, dn, 1, ldsbase, wid, lane);
        const float inv = 1.0f / sum; const int posq = d.qbase + (qi << d.dsh);
        porow = ATT + ((size_t)d.p * SEQ + posq) * 1024 + d.h * 128 + 4 * kg;
#pragma unroll
        for (int dt = 0; dt < 8; ++dt) { pw[dt].x = cvt_pk_bf16(o[dt][0] * inv, o[dt][1] * inv); pw[dt].y = cvt_pk_bf16(o[dt][2] * inv, o[dt][3] * inv); }
        plsep = LSE + ((size_t)d.p * 8 + d.h) * SEQ + posq; plse = mx * 0.6931471805599453f + __logf(sum);
        if (!has_next) break;
        uid = nuid; d = dn;
    }
#pragma unroll
    for (int dt = 0; dt < 8; ++dt) *(u32x2*)(porow + 16 * dt) = pw[dt];
    if (kg == 0) *plsep = plse;
    asm volatile("s_waitcnt vmcnt(0)" ::: "memory"); __syncthreads();
}

__device__ __forceinline__ void phase_mix(const Args& a, int l, LAS unsigned char* lds, int tid, int wid, int lane) {
    { u32x4 pu[4], pv[4];
      if ((int)blockIdx.x < 1024) sgu_fetch(a, (int)blockIdx.x, tid, pu, pv);
#pragma unroll 1
      for (int uid = blockIdx.x; uid < 1024; uid += gridDim.x) sgu_unit(a, l, lds, uid, uid + (int)gridDim.x, tid, wid, lane, pu, pv); }
    attn_units(a, lds, (int)blockIdx.x, tid, wid, lane);
}

__device__ __forceinline__ void phase_attcomb(const Args& a, int l, int wave, int lane) {
    const int gw = blockIdx.x * NWAVES + wave, NGW = gridDim.x * NWAVES;
    const bf16_t* ATT = (const bf16_t*)(a.ws + WS_ATT);
    const float* LSE = (const float*)(a.ws + WS_LSE);
    bf16_t* YM = (bf16_t*)(a.ws + WS_YMIX);
    const int h = lane >> 3, c0 = 16 * lane;
    float gn[16];
#pragma unroll
    for (int j = 0; j < 16; ++j) gn[j] = a.in[I_ONA][l * 1024 + c0 + j];
    for (int m0 = gw; m0 < SEQ; m0 += 2 * NGW) {
        float lsr[2][3]; u32x4 raw[2][3][2];
#pragma unroll
        for (int t = 0; t < 2; ++t) { const int m = (m0 + t * NGW < SEQ) ? m0 + t * NGW : m0;
#pragma unroll
            for (int p = 0; p < 3; ++p) { lsr[t][p] = LSE[((size_t)p * 8 + h) * SEQ + m];
                const bf16_t* src = ATT + ((size_t)p * SEQ + m) * 1024 + c0; raw[t][p][0] = *(const u32x4*)src; raw[t][p][1] = *(const u32x4*)(src + 8); } }
#pragma unroll
        for (int t = 0; t < 2; ++t) { const int m = m0 + t * NGW; if (m >= SEQ) break;
            float o[16];
            const float mxl = fmaxf(lsr[t][0], fmaxf(lsr[t][1], lsr[t][2]));
            float al[3], asum = 0.f;
#pragma unroll
            for (int p = 0; p < 3; ++p) { al[p] = __expf(lsr[t][p] - mxl); asum += al[p]; }
            const float ainv = 1.0f / asum;
#pragma unroll
            for (int j = 0; j < 16; ++j) o[j] = 0.f;
#pragma unroll
            for (int p = 0; p < 3; ++p) { float tt[8]; const float w = al[p] * ainv;
                unpack8(raw[t][p][0], tt);
#pragma unroll
                for (int j = 0; j < 8; ++j) o[j] += w * tt[j];
                unpack8(raw[t][p][1], tt);
#pragma unroll
                for (int j = 0; j < 8; ++j) o[8 + j] += w * tt[j]; }
            float ss = 0.f;
#pragma unroll
            for (int j = 0; j < 16; ++j) ss += o[j] * o[j];
            ss += shx(ss, 1, lane); ss += shx(ss, 2, lane); ss += shx(ss, 4, lane);
            const float rstd = rsqrtf(ss * (1.0f / 128.0f) + NEPS);
            float t0[8], t1[8];
#pragma unroll
            for (int j = 0; j < 8; ++j) { t0[j] = o[j] * rstd * gn[j]; t1[j] = o[8 + j] * rstd * gn[8 + j]; }
#if WOUT_FP8
            { u32x4 w; w.x = pk4_fp8(t0[0] * ASC_H, t0[1] * ASC_H, t0[2] * ASC_H, t0[3] * ASC_H); w.y = pk4_fp8(t0[4] * ASC_H, t0[5] * ASC_H, t0[6] * ASC_H, t0[7] * ASC_H);
              w.z = pk4_fp8(t1[0] * ASC_H, t1[1] * ASC_H, t1[2] * ASC_H, t1[3] * ASC_H); w.w = pk4_fp8(t1[4] * ASC_H, t1[5] * ASC_H, t1[6] * ASC_H, t1[7] * ASC_H);
              *(u32x4*)((unsigned char*)YM + (size_t)m * DM + 1024 + c0) = w; }
#else
            bf16_t* dst = YM + (size_t)m * DM + 1024 + c0;
            *(u32x4*)dst = pack8(t0); *(u32x4*)(dst + 8) = pack8(t1);
#endif
        }
    }
}

constexpr int RSTR = 4112;
__device__ __forceinline__ void phase_router(const Args& a, int l, LAS unsigned char* lds, int tid, int wid, int lane, bool dummy) {
    const float* mod = (const float*)(a.ws + WS_CTL) + CW_MOD + l * 12288;
    const bf16_t* XB = (const bf16_t*)(a.ws + WS_XB); bf16_t* XR = (bf16_t*)(a.ws + (dummy ? WS_DUMMY + 192 * MiB : WS_XR));
    const bf16_t* MD = (const bf16_t*)(a.ws + WS_MIXD);
    unsigned char* H8 = a.ws + (dummy ? WS_DUMMY : WS_H);
    LAS unsigned char* HHI = lds;
    const bf16_t* RTH = (const bf16_t*)(a.ws + WS_RT) + (size_t)l * 262144; const bf16_t* RTL = RTH + 131072;
    unsigned* cnt = (unsigned*)(a.ws + WS_CTL) + CW_CNT + 64 * (l * 64) + (dummy ? 64 * 128 : 0);
    const size_t doff = dummy ? (WS_DUMMY + 64 * MiB - WS_TOKLIST) : 0;
    int* toklist = (int*)(a.ws + doff + WS_TOKLIST); int* toksel = (int*)(a.ws + doff + WS_TOKSEL); float* gwt = (float*)(a.ws + doff + WS_GW);
    f32x4 ga[8], gb[8]; load_mod_vecs(a.in[I_FFNN] + l * DM, mod + 4 * 2048, mod + 3 * 2048, lane, ga, gb);
    const int fr = lane & 15, kg = lane >> 4;
    const float rbias = a.in[I_RB][l * 64 + lane];
    for (int tile = blockIdx.x; tile < SEQ / 32; tile += gridDim.x) {
#pragma unroll 1
        for (int rp = 0; rp < 2; ++rp) { const int r0 = 4 * wid + 2 * rp, m0 = 32 * tile + r0;
            f32x4 v[8], u[8];
            if (l == 0) { load_row(a.in[I_X] + (size_t)m0 * DM, lane, v); load_row(a.in[I_X] + (size_t)(m0 + 1) * DM, lane, u); }
            else {
#pragma unroll
                for (int j = 0; j < 8; ++j) { v[j] = (f32x4){0.f, 0.f, 0.f, 0.f}; u[j] = (f32x4){0.f, 0.f, 0.f, 0.f}; }
                add_row_bf16(XB + (size_t)m0 * DM, lane, v); add_row_bf16(XB + (size_t)(m0 + 1) * DM, lane, u); }
            add_row_bf16(MD + (size_t)m0 * DM, lane, v); add_row_bf16(MD + (size_t)(m0 + 1) * DM, lane, u);
            store_row_bf16(XR + (size_t)m0 * DM, lane, v); store_row_bf16(XR + (size_t)(m0 + 1) * DM, lane, u);
            const float rstd0 = rsqrtf(wave_sum(sumsq8(v), lane) * (1.0f / DM) + NEPS), rstd1 = rsqrtf(wave_sum(sumsq8(u), lane) * (1.0f / DM) + NEPS);
#pragma unroll
            for (int j = 0; j < 8; ++j) { v[j] = v[j] * rstd0 * ga[j] + gb[j]; u[j] = u[j] * rstd1 * ga[j] + gb[j]; }
            store_row_fp8(H8 + (size_t)m0 * DM, lane, v, ASC_H); store_row_fp8(H8 + (size_t)(m0 + 1) * DM, lane, u, ASC_H);
#pragma unroll
            for (int j = 0; j < 4; ++j) { const float f[8] = {v[2 * j][0], v[2 * j][1], v[2 * j][2], v[2 * j][3], v[2 * j + 1][0], v[2 * j + 1][1], v[2 * j + 1][2], v[2 * j + 1][3]};
                *(LAS u32x4*)(HHI + r0 * RSTR + 16 * (64 * j + lane)) = pack8(f);
                const float g[8] = {u[2 * j][0], u[2 * j][1], u[2 * j][2], u[2 * j][3], u[2 * j + 1][0], u[2 * j + 1][1], u[2 * j + 1][2], u[2 * j + 1][3]};
                *(LAS u32x4*)(HHI + (r0 + 1) * RSTR + 16 * (64 * j + lane)) = pack8(g); } }
        __syncthreads();
        {
            f32x4 acc[2][4];
#pragma unroll
            for (int mt = 0; mt < 2; ++mt)
#pragma unroll
                for (int nt = 0; nt < 4; ++nt) acc[mt][nt] = (f32x4){0.f, 0.f, 0.f, 0.f};
#pragma unroll 2
            for (int ks = 0; ks < 8; ++ks) { const int k0 = 256 * wid + 32 * ks + 8 * kg;
                const bf16x8 a0 = *(const LAS bf16x8*)(HHI + fr * RSTR + k0 * 2), a1 = *(const LAS bf16x8*)(HHI + (16 + fr) * RSTR + k0 * 2);
#pragma unroll
                for (int nt = 0; nt < 4; ++nt) { const int fo = (((8 * wid + ks) * 4 + nt) * 64 + lane) << 3; const bf16x8 bh = *(const bf16x8*)(RTH + fo), bl = *(const bf16x8*)(RTL + fo);
                    acc[0][nt] = __builtin_amdgcn_mfma_f32_16x16x32_bf16(a0, bh, acc[0][nt], 0, 0, 0);
                    acc[0][nt] = __builtin_amdgcn_mfma_f32_16x16x32_bf16(a0, bl, acc[0][nt], 0, 0, 0);
                    acc[1][nt] = __builtin_amdgcn_mfma_f32_16x16x32_bf16(a1, bh, acc[1][nt], 0, 0, 0);
                    acc[1][nt] = __builtin_amdgcn_mfma_f32_16x16x32_bf16(a1, bl, acc[1][nt], 0, 0, 0); } }
            __syncthreads();
            LAS float* PART = (LAS float*)lds + wid * 2048;
#pragma unroll
            for (int mt = 0; mt < 2; ++mt)
#pragma unroll
                for (int nt = 0; nt < 4; ++nt)
#pragma unroll
                    for (int rg = 0; rg < 4; ++rg) PART[(16 * mt + 4 * kg + rg) * 64 + 16 * nt + fr] = acc[mt][nt][rg];
        }
        __syncthreads();
        LAS int* SCRI = (LAS int*)(lds + 65536 + wid * 2048); LAS float* SCRF = (LAS float*)(lds + 65536 + wid * 2048 + 1024);
#pragma unroll 1
        for (int rr = 0; rr < 4; ++rr) {
            const int tt = 4 * wid + rr, m = 32 * tile + tt;
            int ln = lane; asm volatile("" : "+v"(ln));
            float lgt = 0.f;
#pragma unroll
            for (int w = 0; w < 8; ++w) lgt += ((const LAS float*)lds)[w * 2048 + tt * 64 + lane];
            const float score = 1.0f / (1.0f + __expf(-lgt));
            const float sel = score + rbias;
            int r8 = 0;
#pragma unroll
            for (int j = 0; j < 8; ++j) { const float o = shl_f(sel, (lane & ~7) + j); r8 += ((o > sel) || (o == sel && j < (ln & 7))) ? 1 : 0; }
            float gs = (r8 < 2) ? sel : 0.f;
            gs += shx(gs, 1, lane); gs += shx(gs, 2, lane); gs += shx(gs, 4, lane);
            int rgp = 0;
#pragma unroll
            for (int j = 0; j < 8; ++j) { const float o = shl_f(gs, 8 * j); rgp += ((o > gs) || (o == gs && j < (ln >> 3))) ? 1 : 0; }
            const bool gsel = rgp < 4;
            const float msel = gsel ? sel : -INFINITY;
            int rk = 0;
#pragma unroll
            for (int j = 0; j < 64; ++j) { const float o = shl_f(msel, j); rk += ((o > msel) || (o == msel && j < ln)) ? 1 : 0; }
            const bool chosen = gsel && rk < 8;
            const float wsum = wave_sum(chosen ? score : 0.f, lane);
            (void)m; SCRI[rr * 64 + lane] = chosen ? rk : -1; SCRF[rr * 64 + lane] = score * (2.5f / wsum);
        }
        {
            int rkc[4]; float gwv[4];
#pragma unroll
            for (int rr = 0; rr < 4; ++rr) { rkc[rr] = SCRI[rr * 64 + lane]; gwv[rr] = SCRF[rr * 64 + lane]; }
            const int nsel = (rkc[0] >= 0 ? 1 : 0) + (rkc[1] >= 0 ? 1 : 0) + (rkc[2] >= 0 ? 1 : 0) + (rkc[3] >= 0 ? 1 : 0);
            unsigned base = 0u; if (nsel > 0) base = atomicAdd(cnt + 64 * lane, (unsigned)nsel);
            int run = 0;
#pragma unroll
            for (int rr = 0; rr < 4; ++rr) if (rkc[rr] >= 0) { const int m = 32 * tile + 4 * wid + rr, pos = (int)base + run; ++run;
                toklist[lane * SEQ + pos] = m; toksel[m * 8 + rkc[rr]] = lane * SEQ + pos; gwt[m * 8 + rkc[rr]] = gwv[rr]; }
        }
        __syncthreads();
    }
}

__device__ __forceinline__ void build_tables(const Args& a, int l, LAS unsigned char* lds, int tid) {
    LAS int* seg = (LAS int*)(lds + LDS_TAB); LAS int* xpre = (LAS int*)(lds + LDS_TAB + 512); LAS int* ntl = (LAS int*)(lds + LDS_TAB + 1024); LAS int* misc = (LAS int*)(lds + LDS_TAB + 1536);
    LAS int* cntl = (LAS int*)(lds + LDS_TOK) + TOK_CAP * 256;
#if GROUP_XCD == 0
    if (tid < 64) {
        const unsigned* cnt = (const unsigned*)(a.ws + WS_CTL) + CW_CNT + 64 * (l * 64);
        const int c = (int)__hip_atomic_load(cnt + 64 * tid, __ATOMIC_RELAXED, __HIP_MEMORY_SCOPE_AGENT); const int nt = (c + 255) >> 8;
        int incl = nt;
#pragma unroll
        for (int o = 1; o < 64; o <<= 1) { const int t = shl_i(incl, tid >= o ? tid - o : tid); if (tid >= o) incl += t; }
        seg[tid] = (incl - nt) * 256; ntl[tid] = nt; cntl[tid] = c; xpre[tid + 1] = incl;
        if (tid == 63) { seg[64] = incl * 256; xpre[65] = incl + 64; }
        if (tid == 0) { xpre[0] = 0; misc[0] = 1; misc[1] = 64; misc[2] = 0; }
    }
#else
    if (tid == 0) {
        const unsigned* cnt = (const unsigned*)(a.ws + WS_CTL) + CW_CNT + 64 * (l * 64);
        int s = 0;
        for (int e = 0; e < 64; ++e) { const int c = (int)__hip_atomic_load(cnt + 64 * e, __ATOMIC_RELAXED, __HIP_MEMORY_SCOPE_AGENT); const int nt = (c + 255) >> 8; seg[e] = s; ntl[e] = nt; cntl[e] = c; s += nt * 256; }
        seg[64] = s;
        const int G = gridDim.x, nv = (GROUP_XCD && G % 8 == 0) ? 8 : 1, nev = 64 / nv, v = (GROUP_XCD == 2) ? (int)blockIdx.x / (G / nv) : (int)blockIdx.x % nv;
        LAS int* rv = misc + 8; LAS int* sh = misc + 16;
        for (int x = 0; x < nv; ++x) { int t = 0; for (int k = 0; k < nev; ++k) t += ntl[x + nv * k]; rv[x] = t; sh[x] = 0; }
        for (int i = 0; i < 64; ++i) { int best = 0; for (int x = 1; x < nv; ++x) if (rv[x] + sh[x] < rv[best] + sh[best]) best = x; sh[best] += 1; }
        int st = 0; for (int x = 0; x < v; ++x) st += sh[x];
        int t = 0; xpre[0] = 0;
        for (int k = 0; k < nev; ++k) { t += ntl[v + nv * k]; xpre[k + 1] = t; }
        xpre[nev + 1] = t + sh[v];
        misc[0] = nv; misc[1] = nev; misc[2] = st;
    }
#endif
    __syncthreads();
}

__device__ __forceinline__ void phase_combine(const Args& a, int l, int wave, int lane, bool dummy) {
    const int gw = blockIdx.x * NWAVES + wave, NGW = gridDim.x * NWAVES;
    const float* mod = (const float*)(a.ws + WS_CTL) + CW_MOD + l * 12288;
    const unsigned char* Y = a.ws + WS_Y;
    const int* toksel = (const int*)(a.ws + WS_TOKSEL); const float* gwt = (const float*)(a.ws + WS_GW);
    const unsigned* cnt = (const unsigned*)(a.ws + WS_CTL) + CW_CNT + 64 * (l * 64);
    bf16_t* H = (bf16_t*)(a.ws + (dummy ? WS_DUMMY + 160 * MiB : WS_H));
    float* dout = dummy ? (float*)(a.ws + WS_DUMMY) : a.out;
    int myc = (((int)__hip_atomic_load(cnt + 64 * lane, __ATOMIC_RELAXED, __HIP_MEMORY_SCOPE_AGENT) + 255) >> 8) << 8, incl = myc;
#pragma unroll
    for (int o = 1; o < 64; o <<= 1) { const int t = shl_i(incl, lane >= o ? lane - o : lane); if (lane >= o) incl += t; }
    const int segstart = incl - myc; const int segsh = shl_i(incl, 63);
    f32x4 gf[8]; load_row(mod + 5 * 2048, lane, gf);
    f32x4 ga[8], gb[8];
    if (l == 0) { const float* mod1 = mod + 12288; load_mod_vecs(a.in[I_MIXN] + DM, mod1 + 2048, mod1, lane, ga, gb); }
    for (int m = gw; m < SEQ; m += NGW) {
        f32x4 v[8], yacc[8];
#pragma unroll
        for (int j = 0; j < 8; ++j) v[j] = (f32x4){0.f, 0.f, 0.f, 0.f};
        add_row_bf16((const bf16_t*)(a.ws + WS_XR) + (size_t)m * DM, lane, v);
#pragma unroll
        for (int j = 0; j < 8; ++j) yacc[j] = (f32x4){0.f, 0.f, 0.f, 0.f};
        int ts_l = 0; float w_l = 0.f;
        if (lane < 8) { ts_l = toksel[m * 8 + lane]; w_l = gwt[m * 8 + lane]; }
        const int slot_l = shl_i(segstart, ts_l >> 14) + (ts_l & 16383);
#pragma unroll 1
        for (int k0 = 0; k0 < 9; k0 += 3) {
            u32x2 q[3][4]; float wsc[3];
#pragma unroll
            for (int kk = 0; kk < 3; ++kk) { const int k = k0 + kk;
                const int slot = (k < 8) ? shl_i(slot_l, k) : segsh + m; const float w = (k < 8) ? shl_f(w_l, k) : 1.0f;
                const unsigned char* yr = Y + (size_t)slot * DM; wsc[kk] = w * (1.0f / YSC);
#pragma unroll
                for (int j = 0; j < 4; ++j) q[kk][j] = *(const u32x2*)(yr + 8 * (64 * j + lane)); }
#pragma unroll
            for (int kk = 0; kk < 3; ++kk) { const float ws = wsc[kk];
#pragma unroll
                for (int j = 0; j < 4; ++j) { const u32x2 qq = q[kk][j];
                    const f32x2 a0 = __builtin_amdgcn_cvt_pk_f32_fp8((int)qq.x, false), a1 = __builtin_amdgcn_cvt_pk_f32_fp8((int)qq.x, true), a2 = __builtin_amdgcn_cvt_pk_f32_fp8((int)qq.y, false), a3 = __builtin_amdgcn_cvt_pk_f32_fp8((int)qq.y, true);
                    yacc[2 * j] += (f32x4){a0.x, a0.y, a1.x, a1.y} * ws; yacc[2 * j + 1] += (f32x4){a2.x, a2.y, a3.x, a3.y} * ws; } }
        }
#pragma unroll
        for (int j = 0; j < 8; ++j) v[j] = v[j] + gf[j] * yacc[j];
        if (l == 0) store_row_bf16((bf16_t*)(a.ws + (dummy ? WS_DUMMY + 128 * MiB : WS_XB)) + (size_t)m * DM, lane, v);
        else {
#pragma unroll
            for (int j = 0; j < 4; ++j) { f32x4* p = (f32x4*)(dout + (size_t)m * DM + 8 * (64 * j + lane)); p[0] = v[2 * j]; p[1] = v[2 * j + 1]; } }
        if (l == 0) {
            const float rstd = rsqrtf(wave_sum(sumsq8(v), lane) * (1.0f / DM) + NEPS);
#pragma unroll
            for (int j = 0; j < 8; ++j) v[j] = v[j] * rstd * ga[j] + gb[j];
#if WIN_FP8
            store_row_fp8((unsigned char*)H + (size_t)m * DM, lane, v, ASC_H);
#else
            store_row_bf16(H + (size_t)m * DM, lane, v);
#endif
        }
    }
}

__device__ __forceinline__ Args fresh_args(const Args& a) {
    long z; asm volatile("s_mov_b64 %0, 0" : "=s"(z));
    Args r;
#pragma unroll
    for (int i = 0; i < 23; ++i) r.in[i] = a.in[i] + z;
    r.out = a.out + z; r.ws = a.ws + z;
    r.ph_lo = a.ph_lo; r.ph_hi = a.ph_hi; return r;
}
#if N_LAUNCH_MODE == 1
#define IN(k) true
#else
#define IN(k) (lo <= (k) && (k) < hi)
#endif
#ifndef PROBE_DUP
#define PROBE_DUP -1
#endif
#define REPS(j) _Pragma("unroll") for (int _rep = 0; _rep < ((PROBE_DUP == (j)) ? 2 : 1); ++_rep)
#define DUMMY(j) ((PROBE_DUP == (j)) && _rep == 0)
#define PBEGIN int ptid; asm volatile("v_mbcnt_lo_u32_b32 %0, -1, 0\n\tv_mbcnt_hi_u32_b32 %0, -1, %0" : "=v"(ptid)); ptid += wave * 64; const int plane = ptid & 63; const int pwave = __builtin_amdgcn_readfirstlane(ptid >> 6); (void)plane; (void)pwave; const Args pa = fresh_args(args); bf16_t* const H = (bf16_t*)(pa.ws + WS_H); bf16_t* const PROJ = (bf16_t*)(pa.ws + WS_PROJ); bf16_t* const YMIX = (bf16_t*)(pa.ws + WS_YMIX); bf16_t* const HID = (bf16_t*)(pa.ws + WS_HID); bf16_t* const Y = (bf16_t*)(pa.ws + WS_Y); unsigned char* const wl = pa.ws + WS_W + (size_t)lyr * W_LAYER; const float* const mod = (const float*)(pa.ws + WS_CTL) + CW_MOD + lyr * 12288; (void)H; (void)PROJ; (void)YMIX; (void)HID; (void)Y; (void)wl; (void)mod;
#define SEAM(k) do { if (IN(k) && IN((k) + 1)) { XcdBarrier b2 = bar; asm volatile("" : "+s"(b2.x)); xcd_barrier(b2); } } while (0)
template <int l>
__device__ __forceinline__ void layer_body(const Args& args, LAS unsigned char* lds, const XcdBarrier& bar, const int wave, const int G) {
    const int lo = args.ph_lo, hi = args.ph_hi; (void)lo; (void)hi;
    const int lyr = l;
        const int pb = 2 + 10 * l;
        if (IN(pb + 0)) REPS(0) { PBEGIN if (l == 0) phase_norm1(pa, 0, pa.in[I_X], pwave, plane); }
        if (l == 0) SEAM(pb + 0);
        if (IN(pb + 1)) REPS(1) { PBEGIN pg8::DenseSched S; S.init(H, wl + W_IN, SEQ, DIN, WIN_FP8 ? DM / 2 : DM, G, (int)blockIdx.x); pg8::EpiProj E{PROJ, pa.in[I_SGUN] + l * 1024, pa.in[I_QN] + l * 128, pa.in[I_KN] + l * 128, (const float*)(pa.ws + WS_ROPE), (LAS float*)(lds + LDS_TAB)};
            pg8::gemm_phase<pg8::EpiProj, pg8::DenseSched, 0, (WIN_FP8 != 0)>(lds, WIN_FP8 ? DM / 2 : DM, S, E, ptid); }
        SEAM(pb + 1);
        if (IN(pb + 3)) REPS(3) { PBEGIN phase_mix(pa, l, lds, ptid, pwave, plane); }
        SEAM(pb + 3);
        if (DIAG_STOP == 3 && l == 0) { PBEGIN const bf16_t* ATT = (const bf16_t*)(pa.ws + WS_ATT) + (size_t)DIAG_P * SEQ * 1024;
            for (size_t i = (size_t)blockIdx.x * NTHREADS + ptid; i < (size_t)SEQ * DM; i += (size_t)gridDim.x * NTHREADS) { const size_t m = i >> 11; const int c = (int)(i & 2047); pa.out[i] = (DIAG_SGU ? c < 1024 : false) ? bf2f(YMIX[m * DM + c]) : (c >= 1024 ? bf2f(ATT[m * 1024 + c - 1024]) : 0.f); }
            return; }
        if (IN(pb + 4)) REPS(4) { PBEGIN phase_attcomb(pa, l, pwave, plane); }
        SEAM(pb + 4);
        if (IN(pb + 5)) REPS(5) { PBEGIN pg8::DenseSched S; S.init(YMIX, wl + W_OUT, SEQ, DM, WOUT_FP8 ? DM / 2 : DM, G, (int)blockIdx.x); pg8::EpiDelta E{(bf16_t*)(pa.ws + (DUMMY(5) ? WS_DUMMY : WS_MIXD)), mod + 2 * 2048, WOUT_FP8 ? 1.0f / (ASC_H * WSC_GU) : 1.0f};
            pg8::gemm_phase<pg8::EpiDelta, pg8::DenseSched, 0, (WOUT_FP8 != 0)>(lds, WOUT_FP8 ? DM / 2 : DM, S, E, ptid); }
        SEAM(pb + 5);
        if (IN(pb + 6)) REPS(6) { PBEGIN phase_router(pa, l, lds, ptid, pwave, plane, DUMMY(6)); }
        SEAM(pb + 6);
        if (IN(pb + 7)) REPS(7) {
            PBEGIN
            build_tables(pa, l, lds, ptid);
            const LAS int* seg = (const LAS int*)(lds + LDS_TAB); LAS int* toks = (LAS int*)(lds + LDS_TOK);
            typedef pg8::GroupSched<DM / 2, 4, true> SchedGU; SchedGU S; S.init(lds, G, (int)blockIdx.x); S.A = (const char*)H; S.Bt = (const char*)(wl + W_GU); S.toks = toks; S.toklist = (const int*)(pa.ws + WS_TOKLIST);
            const unsigned* cnt = (const unsigned*)(pa.ws + WS_CTL) + CW_CNT + 64 * (l * 64); const int* toklist = (const int*)(pa.ws + WS_TOKLIST);
            { pg8::Unit u; const LAS int* cntl = (const LAS int*)(lds + LDS_TOK) + TOK_CAP * 256;
#pragma unroll 1
              for (int i = pwave; i < TOK_CAP; i += NWAVES) { if (!S.next(i, u)) break;
                  const int c = (u.e < 64) ? cntl[u.e] : SEQ;
#pragma unroll
                  for (int r = plane; r < 256; r += 64) { const int rr = u.pm * 256 + r; toks[i * 256 + r] = (rr < c) ? ((u.e < 64) ? toklist[u.e * SEQ + rr] : rr) : 0; } } }
            __syncthreads();
            pg8::EpiGateUp E{(unsigned char*)HID, seg, (PROBE_DUP == 7 && PROBE_NOSTORE && _rep == 0) ? PROBE_NOSTORE : 0};
            pg8::gemm_phase<pg8::EpiGateUp, SchedGU, STAG_GU, true>(lds, DM / 2, S, E, ptid);
        }
        SEAM(pb + 7);
        if (IN(pb + 8)) REPS(8) {
            PBEGIN
            build_tables(pa, l, lds, ptid);
            const LAS int* seg = (const LAS int*)(lds + LDS_TAB);
            typedef pg8::GroupSched<256, 8, false> SchedD; SchedD S; S.init(lds, G, (int)blockIdx.x); S.A = (const char*)HID; S.Bt = (const char*)(wl + W_D); S.toks = seg; S.toklist = nullptr;
            pg8::EpiY8 E{(unsigned char*)Y, seg};
            pg8::gemm_phase<pg8::EpiY8, SchedD, STAG_D, true>(lds, 256, S, E, ptid);
        }
        SEAM(pb + 8);
        if (IN(pb + 9)) REPS(9) { PBEGIN phase_combine(pa, l, pwave, plane, DUMMY(9)); }
        if (l == 0) SEAM(pb + 9);
}
constexpr int NPHASE = 22;
__global__ void __launch_bounds__(NTHREADS, 2) trunk_fwd(Args args) {
    extern __shared__ __attribute__((aligned(16))) unsigned char lds_raw[];
    LAS unsigned char* lds = (LAS unsigned char*)lds_raw;
    const int tid = threadIdx.x, lane = tid & 63, wave = __builtin_amdgcn_readfirstlane(tid >> 6);
    volatile LAS unsigned* MISC = (volatile LAS unsigned*)(lds + LDS_MISC);
    if (tid < 64) ((LAS unsigned*)(lds + LDS_MISC))[tid] = 0u;
    __syncthreads();
    unsigned* ctl = (unsigned*)(args.ws + WS_CTL);
    XcdBarrier bar = xcd_barrier_post(ctl + CW_BAR, MISC);
    const int lo = args.ph_lo, hi = args.ph_hi; (void)lo; (void)hi;
    const int G = gridDim.x;
    const int lyr = 0;

    if (IN(0)) REPS(100) { PBEGIN phase_prologue(pa, lds, ptid, pwave, plane); }
    SEAM(0);
    if (IN(1)) { PBEGIN phase_modreduce(pa, ptid); }
    SEAM(1);
    layer_body<0>(args, lds, bar, wave, G);
    if (DIAG_STOP >= 0) return;
    layer_body<1>(args, lds, bar, wave, G);
#undef IN
#undef SEAM
}

extern "C" void kernel_launch(void* const* d_in, const int* in_sizes, int n_in, void* d_out, int out_size, void* d_ws, size_t ws_size, hipStream_t stream) {
    static int grid = 0;
    if (grid == 0) {
        if (n_in != 23 || out_size != SEQ * DM || ws_size < WS_NEED) { fprintf(stderr, "kernel_launch: unexpected shapes (n_in %d, out %d, ws %zu < %zu)\n", n_in, out_size, ws_size, (size_t)WS_NEED); grid = -1; return; }
        int dev = 0, cus = 0, per_cu = 0;
        if (hipGetDevice(&dev) != hipSuccess || hipDeviceGetAttribute(&cus, hipDeviceAttributeMultiprocessorCount, dev) != hipSuccess) { grid = -1; return; }
        if (hipFuncSetAttribute((const void*)trunk_fwd, hipFuncAttributeMaxDynamicSharedMemorySize, LDS_BYTES) != hipSuccess) { fprintf(stderr, "kernel_launch: hipFuncSetAttribute failed\n"); grid = -1; return; }
        if (hipOccupancyMaxActiveBlocksPerMultiprocessor(&per_cu, (const void*)trunk_fwd, NTHREADS, LDS_BYTES) != hipSuccess || per_cu < 1) { fprintf(stderr, "kernel_launch: occupancy query says %d\n", per_cu); }
        (void)hipGetLastError();
        grid = cus;
    }
    if (grid < 0) return;
    (void)hipMemsetAsync((char*)d_ws + WS_CTL, 0, CTL_BYTES, stream);
    Args a{};
    for (int i = 0; i < 23; ++i) a.in[i] = (const float*)d_in[i];
    a.out = (float*)d_out; a.ws = (unsigned char*)d_ws;
#if N_LAUNCH_MODE == 1
    a.ph_lo = 0; a.ph_hi = NPHASE;
    hipLaunchKernelGGL(trunk_fwd, dim3(grid), dim3(NTHREADS), LDS_BYTES, stream, a);
#else
    for (int ph = 0; ph < NPHASE; ++ph) {
        if (ph == 12) continue;
        a.ph_lo = ph; a.ph_hi = ph + 1;
        hipLaunchKernelGGL(trunk_fwd, dim3(grid), dim3(NTHREADS), LDS_BYTES, stream, a);
    }
#endif
}
```

```cpp
#include <hip/hip_runtime.h>
#include <cstdio>
#include <cstdint>
#include <cmath>

#ifndef PROBE_NOSTORE
#define PROBE_NOSTORE 0
#endif
#ifndef ATT_PIPE
#define ATT_PIPE 1
#endif
#ifndef ATT_CLEAR
#define ATT_CLEAR 0
#endif
#ifndef ATT_CHK_TILE
#define ATT_CHK_TILE 99
#endif
#ifndef ATT_VOLD
#define ATT_VOLD 0
#endif
#ifndef ATT_KGLOBAL
#define ATT_KGLOBAL 0
#endif
#ifndef DIAG_P
#define DIAG_P 0
#endif
#ifndef DIAG_SGU
#define DIAG_SGU 1
#endif
#ifndef DIAG_NOTR
#define DIAG_NOTR 1
#endif
#ifndef DIAG_STOP
#define DIAG_STOP -1
#endif
#ifndef WIN_FP8
#define WIN_FP8 1
#endif
#ifndef WOUT_FP8
#define WOUT_FP8 1
#endif
#ifndef STAG_D
#define STAG_D 0
#endif
#ifndef STAG_GU
#define STAG_GU 0
#endif
#ifndef GROUP_XCD
#define GROUP_XCD 0
#endif
#ifndef GROUP_PERM
#define GROUP_PERM 1
#endif
#ifndef N_LAUNCH_MODE
#define N_LAUNCH_MODE 1
#endif

#define LAS __attribute__((address_space(3)))
typedef unsigned short bf16_t;
typedef short bf16x8 __attribute__((ext_vector_type(8)));
typedef short s16x4 __attribute__((ext_vector_type(4)));
typedef float f32x4 __attribute__((ext_vector_type(4)));
typedef float f32x2 __attribute__((ext_vector_type(2)));
typedef unsigned u32x4 __attribute__((ext_vector_type(4)));
typedef unsigned u32x2 __attribute__((ext_vector_type(2)));

constexpr int SEQ = 16384, DM = 2048, DIN = 5120, NEXP = 64, NEXS = 65, NLAYER = 2;
constexpr float NEPS = 1e-6f;
constexpr float WSC_GU = 64.f, WSC_D = 32.f, ASC_H = 8.f, ASC_HID = 8.f, YSC = 16.f;
constexpr int NWAVES = 8, NTHREADS = 512;
constexpr int HID_ROWS = 131072 + 64 * 256 + 16384;

constexpr size_t MiB = 1u << 20;
constexpr size_t WS_CTL = 0, CTL_BYTES = 1 * MiB;
constexpr int CW_BAR = 4096;
constexpr int CW_CNT = 8192;
constexpr int CW_MOD = 32768;
constexpr size_t WS_ROPE = 1 * MiB;
constexpr size_t WS_SGUW = 3 * MiB;
constexpr size_t WS_RT = 4 * MiB;
constexpr size_t WS_TOKLIST = 5 * MiB;
constexpr size_t WS_TOKSEL = 9 * MiB;
constexpr size_t WS_GW = 9 * MiB + 512 * 1024;
constexpr size_t WS_LSE = 10 * MiB;
constexpr size_t WS_MODP = 11 * MiB + 512 * 1024;
constexpr size_t WS_W = 16 * MiB;
constexpr size_t W_IN = 0, W_OUT = 20 * MiB, W_GU = 28 * MiB, W_D = W_GU + 65 * 4 * MiB, W_LAYER = W_D + 65 * 2 * MiB;
constexpr size_t WS_H = WS_W + 2 * W_LAYER;
constexpr size_t WS_HID = WS_H + 64 * MiB;
constexpr size_t WS_Y = WS_HID + (size_t)HID_ROWS * 1024;
constexpr size_t WS_PROJ = WS_Y;
constexpr size_t WS_YMIX = WS_PROJ + 160 * MiB;
constexpr size_t WS_ATT = WS_YMIX + 64 * MiB;
constexpr size_t WS_MIXD = WS_Y + 320 * MiB;
constexpr size_t WS_END = WS_Y + (size_t)HID_ROWS * 4096;
static_assert(WS_ATT + 96 * MiB <= WS_END, "overlay");
constexpr size_t WS_DUMMY = WS_END;
constexpr size_t WS_XR = WS_DUMMY;
constexpr size_t WS_XB = WS_DUMMY + 64 * MiB;
constexpr size_t WS_NEED = WS_END + 300 * MiB;

constexpr int LDS_BYTES = 147456;
constexpr int LDS_TAB = 131072;
constexpr int LDS_TOK = 133120;
constexpr int TOK_CAP = 13;
constexpr int LDS_MISC = 147200;

__device__ __forceinline__ unsigned cvt_pk_bf16(float lo, float hi) { unsigned r; asm volatile("v_cvt_pk_bf16_f32 %0, %1, %2" : "=v"(r) : "v"(lo), "v"(hi)); return r; }
__device__ __forceinline__ float bf_lo(unsigned w) { return __uint_as_float(w << 16); }
__device__ __forceinline__ float bf_hi(unsigned w) { return __uint_as_float(w & 0xffff0000u); }
__device__ __forceinline__ float bf2f(bf16_t b) { return __uint_as_float(((unsigned)b) << 16); }
__device__ __forceinline__ float shx(float v, int m, int lane) { return __int_as_float(__builtin_amdgcn_ds_bpermute((lane ^ m) << 2, __float_as_int(v))); }
__device__ __forceinline__ float shl_f(float v, int src) { return __int_as_float(__builtin_amdgcn_ds_bpermute(src << 2, __float_as_int(v))); }
__device__ __forceinline__ int shl_i(int v, int src) { return __builtin_amdgcn_ds_bpermute(src << 2, v); }
__device__ __forceinline__ float wave_sum(float v, int lane) {
#pragma unroll
    for (int o = 1; o < 64; o <<= 1) v += shx(v, o, lane);
    return v;
}
__device__ __forceinline__ f32x2 gelu_pk(f32x2 v) {
    const f32x2 av = __builtin_elementwise_abs(v), d = av * 0.2316418882f + 1.0f;
    f32x2 t; t.x = __builtin_amdgcn_rcpf(d.x); t.y = __builtin_amdgcn_rcpf(d.y);
    f32x2 q = t * 0.5307027145f + (-0.7265760135f); q = q * t + 0.7107068705f; q = q * t + (-0.142248368f); q = q * t + 0.127414796f; q = q * t;
    const f32x2 s = (v * v) * (-0.72134752044f);
    f32x2 e; e.x = __builtin_amdgcn_exp2f(s.x); e.y = __builtin_amdgcn_exp2f(s.y);
    const f32x2 m = v * (q * e), r = v - m;
    f32x2 o; o.x = v.x < 0.f ? m.x : r.x; o.y = v.y < 0.f ? m.y : r.y; return o;
}
__device__ __forceinline__ float gelu1(float x) { f32x2 v = {x, 0.f}; return gelu_pk(v).x; }
__device__ __forceinline__ float silu1(float x) { return x * __builtin_amdgcn_rcpf(1.0f + __expf(-x)); }
__device__ __forceinline__ s16x4 lds_tr(const LAS unsigned char* p) { return __builtin_bit_cast(s16x4, __builtin_amdgcn_ds_read_tr16_b64_v4i16((LAS s16x4*)p)); }
__device__ __forceinline__ bf16x8 cat4(s16x4 a, s16x4 b) { bf16x8 r; r[0] = a[0]; r[1] = a[1]; r[2] = a[2]; r[3] = a[3]; r[4] = b[0]; r[5] = b[1]; r[6] = b[2]; r[7] = b[3]; return r; }
__device__ __forceinline__ unsigned pk4_fp8(float a, float b, float c, float d) {
    a = fminf(fmaxf(a, -448.f), 448.f); b = fminf(fmaxf(b, -448.f), 448.f); c = fminf(fmaxf(c, -448.f), 448.f); d = fminf(fmaxf(d, -448.f), 448.f);
    int w = 0; w = __builtin_amdgcn_cvt_pk_fp8_f32(a, b, w, false); w = __builtin_amdgcn_cvt_pk_fp8_f32(c, d, w, true); return (unsigned)w; }
__device__ __forceinline__ void unpack8(const u32x4 w, float (&f)[8]) { f[0] = bf_lo(w.x); f[1] = bf_hi(w.x); f[2] = bf_lo(w.y); f[3] = bf_hi(w.y); f[4] = bf_lo(w.z); f[5] = bf_hi(w.z); f[6] = bf_lo(w.w); f[7] = bf_hi(w.w); }
__device__ __forceinline__ u32x4 pack8(const float (&f)[8]) { u32x4 w; w.x = cvt_pk_bf16(f[0], f[1]); w.y = cvt_pk_bf16(f[2], f[3]); w.z = cvt_pk_bf16(f[4], f[5]); w.w = cvt_pk_bf16(f[6], f[7]); return w; }

#define XB_TMO      128
#define XB_XCNT(j)  (256  + 64 * (j))
#define XB_XSUB(j)  (1280 + 64 * (j))
#define XB_XGEN(j)  (2304 + 64 * (j))
#define XB_TOP      3328
#define XB_TOPGEN   3392
#define XCD_BAR_WORDS 3456
#define XB_SPIN_CAP (1u << 18)
__device__ __forceinline__ unsigned xb_ld(unsigned* p)              { return __hip_atomic_load(p, __ATOMIC_RELAXED, __HIP_MEMORY_SCOPE_AGENT); }
__device__ __forceinline__ unsigned xb_add(unsigned* p, unsigned v) { return __hip_atomic_fetch_add(p, v, __ATOMIC_RELAXED, __HIP_MEMORY_SCOPE_AGENT); }
__device__ __forceinline__ unsigned xb_xcc_id() { return (unsigned)__builtin_amdgcn_s_getreg((3 << 11) | 20) & 0xFu; }
#define XB_SPIN(cond, bar) do { unsigned _sp = 0; while (cond) { __builtin_amdgcn_s_sleep(1); \
    if ((++_sp & 255u) == 0u) { if (xb_ld(&(bar)[XB_TMO])) break; if (_sp > XB_SPIN_CAP) { atomicAdd(&(bar)[XB_TMO], 1u); break; } } } } while (0)
struct XcdBarrier { unsigned* bar; unsigned x; volatile LAS unsigned* st; };
__device__ __forceinline__ XcdBarrier xcd_barrier_post(unsigned* bar, volatile LAS unsigned* st) {
    XcdBarrier b; b.bar = bar; b.x = xb_xcc_id(); b.st = st;
    if (threadIdx.x == 0) (void)xb_add(&bar[XB_XCNT(b.x)], 1u);
    return b;
}
__device__ __forceinline__ void xcd_barrier_complete(unsigned* bar, unsigned x, unsigned& nloc, unsigned& nx) {
    const unsigned G = gridDim.x * gridDim.y * gridDim.z;
    unsigned sum, cnt, mine, sp = 0u;
    for (;;) {
        sum = 0u; cnt = 0u; mine = 0u;
#pragma unroll
        for (unsigned j = 0; j < 16; ++j) { const unsigned c = xb_ld(&bar[XB_XCNT(j)]); sum += c; cnt += (c > 0u) ? 1u : 0u; mine = (j == x) ? c : mine; }
        if (sum == G) break;
        __builtin_amdgcn_s_sleep(1);
        if ((++sp & 255u) == 0u) { if (xb_ld(&bar[XB_TMO])) break; if (sp > XB_SPIN_CAP) { atomicAdd(&bar[XB_TMO], 1u); break; } }
    }
    nloc = mine > 0u ? mine : 1u; nx = cnt > 0u ? cnt : 1u;
}
__device__ __forceinline__ void xcd_barrier(const XcdBarrier& b) {
    asm volatile("s_waitcnt vmcnt(0)" ::: "memory");
    __syncthreads();
    if (threadIdx.x == 0) {
        unsigned* bar = b.bar;
        __builtin_amdgcn_s_waitcnt(0);
        unsigned nloc = b.st[0], nx = b.st[1];
        if (nloc == 0u) { xcd_barrier_complete(bar, b.x, nloc, nx); b.st[0] = nloc; b.st[1] = nx; }
        const unsigned old = xb_add(&bar[XB_XSUB(b.x)], 1u);
        const unsigned gen = old / nloc;
        if (old + 1u == (gen + 1u) * nloc) {
            __builtin_amdgcn_fence(__ATOMIC_RELEASE, "agent");
            asm volatile("s_waitcnt vmcnt(0)" ::: "memory");
            const unsigned og = xb_add(&bar[XB_TOP], 1u);
            const unsigned tg = og / nx;
            if (og + 1u == (tg + 1u) * nx) xb_add(&bar[XB_TOPGEN], 1u);
            else XB_SPIN(xb_ld(&bar[XB_TOPGEN]) == tg, bar);
            __builtin_amdgcn_fence(__ATOMIC_ACQUIRE, "agent");
            xb_add(&bar[XB_XGEN(b.x)], 1u);
            asm volatile("s_waitcnt vmcnt(0)" ::: "memory");
        } else {
            XB_SPIN(xb_ld(&bar[XB_XGEN(b.x)]) == gen, bar);
            __builtin_amdgcn_fence(__ATOMIC_ACQUIRE, "agent");
            asm volatile("s_waitcnt vmcnt(0)" ::: "memory");
        }
    }
    __syncthreads();
}

namespace pg8 {
typedef int v8i __attribute__((ext_vector_type(8)));
__device__ __forceinline__ v8i cat8(bf16x8 a, bf16x8 b) { typedef int v4i __attribute__((ext_vector_type(4))); const v4i x = __builtin_bit_cast(v4i, a), y = __builtin_bit_cast(v4i, b); return __builtin_shufflevector(x, y, 0, 1, 2, 3, 4, 5, 6, 7); }
constexpr int BM = 256, BK = 64, HALF = 128, HTB = HALF * BK * 2, STAGE_BYTES = 8 * HTB, NXCD = 8, WGM = 8;
__host__ __device__ __forceinline__ int lds_byte(int r, int c) { return (r >> 3) * 1024 + (r & 7) * 128 + ((((c >> 3) ^ (r >> 1)) & 7) << 4) + (c & 7) * 2; }
__host__ __device__ __forceinline__ void stage_rc(int b, int& R, int& C) { const int blk = b / 1024, rr = (b % 1024) / 128, cp = (b % 128) / 16; R = blk * 8 + rr; C = ((cp ^ (R >> 1)) & 7) * 8; }
__host__ __device__ __forceinline__ int perm32(int rho) { const int n = rho >> 4, i = rho & 15; return 8 * (i >> 2) + 4 * n + (i & 3); }

struct Unit { int pm, pn, e, ord; };

struct DenseSched {
    static constexpr bool GATHER = false;
    const char* A; const char* Bt; int K, nM, nN, nwg, G, c;
    __device__ void init(const void* A_, const void* Bt_, int M, int N, int K_, int G_, int c_) { A = (const char*)A_; Bt = (const char*)Bt_; K = K_; nM = M / BM; nN = N / BM; nwg = nM * nN; G = G_; c = c_; }
    __device__ __forceinline__ bool next(int i, Unit& u) const {
        const long L = (long)i * G + c; if (L >= nwg) return false;
        int wgid = (int)L; { const int q = nwg / NXCD, r = nwg % NXCD, xcd = wgid % NXCD, off = wgid / NXCD; wgid = (xcd < r ? xcd * (q + 1) : r * (q + 1) + (xcd - r) * q) + off; }
        const int nig = WGM * nN, gid = wgid / nig, fm = gid * WGM, gsz = (nM - fm) < WGM ? (nM - fm) : WGM;
        u.pm = fm + ((wgid % nig) % gsz); u.pn = (wgid % nig) / gsz; u.e = 0; u.ord = i; return true;
    }
    __device__ __forceinline__ void locate(const Unit& u, const char*& a, const char*& b) const { a = A + (size_t)u.pm * BM * K * 2; b = Bt + (size_t)u.pn * BM * K * 2; }
    __device__ __forceinline__ unsigned arow(const Unit&, int row) const { return (unsigned)(row * K) * 2u; }
};
template <int KK, int NTN, bool GATHER_>
struct GroupSched {
    static constexpr bool GATHER = GATHER_;
    const char* A; const char* Bt; const LAS int* seg; const LAS int* xpre_; const LAS int* toks; const int* toklist;
    int nv, nev, v, rank, W, sh_start;
    static constexpr size_t bstride = (size_t)NTN * BM * KK * 2;
    __device__ __forceinline__ void init(const LAS unsigned char* lds, int G, int c) {
        seg = (const LAS int*)(lds + LDS_TAB); xpre_ = (const LAS int*)(lds + LDS_TAB + 512);
        const LAS int* misc = (const LAS int*)(lds + LDS_TAB + 1536);
        nv = __builtin_amdgcn_readfirstlane(misc[0]); nev = __builtin_amdgcn_readfirstlane(misc[1]); sh_start = __builtin_amdgcn_readfirstlane(misc[2]);
        W = G / nv;
#if GROUP_XCD == 2
        v = c / W; rank = c % W;
#else
        v = c % nv; rank = c / nv;
#endif
#if GROUP_PERM
        if (G % NXCD == 0) rank = __builtin_amdgcn_readfirstlane((c % NXCD) * (G / NXCD) + c / NXCD);
#endif
    }
    __device__ __forceinline__ bool next(int i, Unit& u) const {
        unsigned xa = (unsigned)(size_t)xpre_; asm volatile("" : "+s"(xa)); const LAS int* xpre = (const LAS int*)(size_t)xa;
        const int q = rank + i * W; const int mtq = q / NTN; const int total = xpre[nev + 1];
        if (mtq >= total) return false;
        int k; { int ll; asm volatile("v_mbcnt_lo_u32_b32 %0, -1, 0\n\tv_mbcnt_hi_u32_b32 %0, -1, %0" : "=v"(ll));
            const int xv = (ll < nev) ? xpre[ll + 1] : 0x7fffffff;
            k = __builtin_popcountll(__builtin_amdgcn_ballot_w64(xv <= mtq)); }
        k = __builtin_amdgcn_readfirstlane(k);
        const int off = __builtin_amdgcn_readfirstlane(mtq - xpre[k]);
        if (k < nev) { u.e = v + nv * k; u.pm = off; } else { u.e = 64; u.pm = sh_start + off; }
        u.pn = q % NTN; u.ord = i; return true;
    }
    __device__ __forceinline__ void locate(const Unit& u, const char*& a, const char*& b) const {
        b = Bt + (size_t)u.e * bstride + (size_t)u.pn * BM * KK * 2;
        a = GATHER ? A : A + (size_t)(seg[u.e] + u.pm * BM) * KK * 2;
    }
    __device__ __forceinline__ unsigned arow(const Unit& u, int row) const {
        int t;
        if (u.ord < TOK_CAP) t = toks[u.ord * 256 + row];
        else { const int rr = u.pm * 256 + row; t = rr;
            if (u.e < 64) { const unsigned off = (unsigned)(u.e * SEQ + rr) * 4u; int tl;
                asm volatile("global_load_dword %0, %1, %2\n\ts_waitcnt vmcnt(0)" : "=&v"(tl) : "v"(off), "s"(toklist) : "memory");
                t = (rr < toks[TOK_CAP * 256 + u.e]) ? tl : 0; } }
        return (unsigned)t * (unsigned)(KK * 2);
    }
};

template <class Epi, class Sched, int STAG = 0, bool FP8 = false>
__device__ __forceinline__ void gemm_phase(LAS unsigned char* lds, const int K, const Sched& S, const Epi& E, const int tid) {
    if (STAG > 0) {
        const unsigned long long t0 = __builtin_amdgcn_s_memrealtime(); const unsigned long long target = (unsigned long long)(((blockIdx.x >> 3) & 3) * STAG);
        while (__builtin_amdgcn_s_memrealtime() - t0 < target) __builtin_amdgcn_s_sleep(8);
    }
    const int wid = __builtin_amdgcn_readfirstlane(tid >> 6), lane = tid & 63, wr = wid >> 2, wc = wid & 3, fr = lane & 15, fq = lane >> 4;
    const int nt = K / BK;
    constexpr bool GATHER = Sched::GATHER;
    unsigned voffB[2], vaC[2][2];
#define PG8_SETVB() do { int _t; asm volatile("v_mbcnt_lo_u32_b32 %0, -1, 0\n\tv_mbcnt_hi_u32_b32 %0, -1, %0" : "=v"(_t)); _t += wid * 64; _Pragma("unroll") for (int _i = 0; _i < 2; ++_i) { int _R, _C; stage_rc(_t * 16 + _i * 8192, _R, _C); \
        const int _Rb = Epi::PERM ? ((_R & ~31) + perm32(_R & 31)) : _R; voffB[_i] = (unsigned)(_Rb * K + _C) * 2u; if (!GATHER) vaC[0][_i] = (unsigned)(_R * K + _C) * 2u; } } while (0)
    const size_t kstep = (size_t)(BK * 2);
    const size_t hstepB = (size_t)HALF * K * 2;
#define PG8_SETVA(u) do { int _t; asm volatile("v_mbcnt_lo_u32_b32 %0, -1, 0\n\tv_mbcnt_hi_u32_b32 %0, -1, %0" : "=v"(_t)); _t += wid * 64; _Pragma("unroll") for (int _h = 0; _h < (GATHER ? 2 : 1); ++_h) _Pragma("unroll") for (int _i = 0; _i < 2; ++_i) { int _R, _C; stage_rc(_t * 16 + _i * 8192, _R, _C); \
        vaC[_h][_i] = (GATHER ? S.arow(u, _h * HALF + _R) : (unsigned)(_R * K) * 2u) + (unsigned)_C * 2u; } } while (0)
    const unsigned ldsw = (unsigned)wid * 1024u;
    const unsigned ldsb = (unsigned)(size_t)lds + ldsw;
    const int aoff = lds_byte(wr * 64 + fr, fq * 8), boff = lds_byte(wc * 32 + fr, fq * 8);
    unsigned abv = (unsigned)(size_t)lds + (unsigned)aoff, bbv = (unsigned)(size_t)lds + 65536u + (unsigned)boff; asm volatile("" : "+v"(abv), "+v"(bbv));
    const LAS unsigned char* abase = (const LAS unsigned char*)(size_t)abv; const LAS unsigned char* bbase = (const LAS unsigned char*)(size_t)bbv;
    unsigned abv2 = (unsigned)(size_t)lds + (unsigned)(aoff ^ 64), bbv2 = (unsigned)(size_t)lds + 65536u + (unsigned)(boff ^ 64); asm volatile("" : "+v"(abv2), "+v"(bbv2));
    const LAS unsigned char* abase2 = (const LAS unsigned char*)(size_t)abv2; const LAS unsigned char* bbase2 = (const LAS unsigned char*)(size_t)bbv2;
#define PG8_SA(b, h) (((b) * 2 + (h)) * HTB)
#define PG8_SB(b, h) ((4 + (b) * 2 + (h)) * HTB)
#define PG8_GLDS(sbase, voff, ldsaddr) do { unsigned _keep; asm volatile("s_mov_b32 %0, m0\n\ts_mov_b32 m0, %3\n\ts_nop 0\n\tglobal_load_lds_dwordx4 %1, %2\n\ts_mov_b32 m0, %0" : "=&s"(_keep) : "v"(voff), "s"(sbase), "s"(ldsaddr) : "memory"); } while (0)
#define PG8_STAGE_B(bufoff, gbase) do { _Pragma("unroll") for (int _i = 0; _i < 2; ++_i) PG8_GLDS((const char*)(gbase), voffB[_i], ldsb + (unsigned)((bufoff) + _i * 8192)); } while (0)
#define PG8_STAGE_A(bufoff, gbase, h) do { _Pragma("unroll") for (int _i = 0; _i < 2; ++_i) \
        PG8_GLDS((const char*)(gbase) + (GATHER ? (size_t)0 : (size_t)(h) * hstepB), vaC[GATHER ? (h) : 0][_i], ldsb + (unsigned)((bufoff) + _i * 8192)); } while (0)
#define PG8_LDA(dst, b, h) do { _Pragma("unroll") for (int m = 0; m < 4; ++m) { if constexpr (FP8) { dst##8[m] = cat8(*(const LAS bf16x8*)(abase + (PG8_SA(b, h) + m * 2048)), *(const LAS bf16x8*)(abase2 + (PG8_SA(b, h) + m * 2048))); } \
        else { _Pragma("unroll") for (int k = 0; k < 2; ++k) dst[m][k] = *(const LAS bf16x8*)((k ? abase2 : abase) + (PG8_SA(b, h) + m * 2048)); } } } while (0)
#define PG8_LDB(dst, b, h) do { _Pragma("unroll") for (int n = 0; n < 2; ++n) { if constexpr (FP8) { dst##8[n] = cat8(*(const LAS bf16x8*)(bbase + (PG8_SB(b, h) - 65536 + n * 2048)), *(const LAS bf16x8*)(bbase2 + (PG8_SB(b, h) - 65536 + n * 2048))); } \
        else { _Pragma("unroll") for (int k = 0; k < 2; ++k) dst[n][k] = *(const LAS bf16x8*)((k ? bbase2 : bbase) + (PG8_SB(b, h) - 65536 + n * 2048)); } } } while (0)
#define PG8_MMA(ai, bj, At, Bt) do { __builtin_amdgcn_s_setprio(1); _Pragma("unroll") for (int m = 0; m < 4; ++m) _Pragma("unroll") for (int n = 0; n < 2; ++n) { \
        if constexpr (FP8) { acc[ai][bj][m][n] = __builtin_amdgcn_mfma_scale_f32_16x16x128_f8f6f4(Bt##8[n], At##8[m], acc[ai][bj][m][n], 0, 0, 0, 0x7F7F7F7F, 0, 0x7F7F7F7F); } \
        else { _Pragma("unroll") for (int k = 0; k < 2; ++k) acc[ai][bj][m][n] = __builtin_amdgcn_mfma_f32_16x16x32_bf16(Bt[n][k], At[m][k], acc[ai][bj][m][n], 0, 0, 0); } } \
        __builtin_amdgcn_s_setprio(0); } while (0)
#define PG8_WAIT_V(n) asm volatile("s_waitcnt vmcnt(" #n ")" ::: "memory")
#define PG8_WAIT_L(n) asm volatile("s_waitcnt lgkmcnt(" #n ")" ::: "memory")
#define PG8_BAR __builtin_amdgcn_s_barrier()
#define PG8_SCHED __builtin_amdgcn_sched_barrier(0)
    Unit cur, nxt; int ui = 0;
    if (!S.next(0, cur)) return;
    f32x4 acc[2][2][4][2];
#pragma unroll
    for (int a = 0; a < 2; ++a)
#pragma unroll
        for (int b = 0; b < 2; ++b)
#pragma unroll
            for (int m = 0; m < 4; ++m)
#pragma unroll
                for (int n = 0; n < 2; ++n) acc[a][b][m][n] = (f32x4){0.f, 0.f, 0.f, 0.f};
    bf16x8 At[4][2], B0[2][2], B1[2][2]; v8i At8[4], B08[2], B18[2];
    const char* cA; const char* cB; S.locate(cur, cA, cB);
    PG8_SETVB();
    if (GATHER) PG8_SETVA(cur);
    PG8_STAGE_B(PG8_SB(0, 0), cB); PG8_STAGE_B(PG8_SB(0, 1), cB + hstepB); PG8_STAGE_A(PG8_SA(0, 0), cA, 0); PG8_STAGE_A(PG8_SA(0, 1), cA, 1);
    if (wr == 1) PG8_BAR;
    PG8_WAIT_V(2); PG8_BAR;
    PG8_STAGE_B(PG8_SB(1, 0), cB + kstep); PG8_STAGE_A(PG8_SA(1, 0), cA + kstep, 0); PG8_STAGE_B(PG8_SB(1, 1), cB + hstepB + kstep);
    PG8_WAIT_V(6); PG8_BAR;
    for (;;) {
        const bool has_next = S.next(ui + 1, nxt);
        const char* nA = cA; const char* nB = cB;
        if (has_next) S.locate(nxt, nA, nB);
#pragma unroll 1
        for (int t = 0; t < nt; t += 2) {
            const bool last = (t == nt - 2);
            asm volatile("" : "+s"(cA), "+s"(cB), "+s"(nA), "+s"(nB));
            PG8_SETVB();
            const char* a1 = cA + (size_t)(t + 1) * kstep;
            const char* a2 = last ? nA : cA + (size_t)(t + 2) * kstep; const char* b2 = last ? nB : cB + (size_t)(t + 2) * kstep;
            const char* a3 = a2 + kstep; const char* b3 = b2 + kstep;
            PG8_LDB(B0, 0, 0); PG8_LDB(B1, 0, 1); PG8_SCHED; PG8_LDA(At, 0, 0); PG8_STAGE_A(PG8_SA(1, 1), a1, 1);
            if (GATHER && last && has_next) PG8_SETVA(nxt);
            PG8_WAIT_V(8); PG8_WAIT_L(0); PG8_BAR; PG8_MMA(0, 0, At, B0); PG8_MMA(0, 1, At, B1); PG8_BAR; PG8_SCHED;
            PG8_LDA(At, 0, 1); PG8_STAGE_B(PG8_SB(0, 0), b2); PG8_STAGE_B(PG8_SB(0, 1), b2 + hstepB); PG8_STAGE_A(PG8_SA(0, 0), a2, 0);
            PG8_WAIT_V(8); PG8_WAIT_L(0); PG8_BAR; PG8_MMA(1, 0, At, B0); PG8_MMA(1, 1, At, B1); PG8_BAR; PG8_SCHED;
            PG8_LDB(B0, 1, 0); PG8_LDB(B1, 1, 1); PG8_SCHED; PG8_LDA(At, 1, 0); PG8_STAGE_A(PG8_SA(0, 1), a2, 1);
            PG8_WAIT_V(8); PG8_WAIT_L(0); PG8_BAR; PG8_MMA(0, 0, At, B0); PG8_MMA(0, 1, At, B1); PG8_BAR; PG8_SCHED;
            PG8_LDA(At, 1, 1); PG8_STAGE_B(PG8_SB(1, 0), b3); PG8_STAGE_B(PG8_SB(1, 1), b3 + hstepB); PG8_STAGE_A(PG8_SA(1, 0), a3, 0);
            PG8_WAIT_V(8); PG8_WAIT_L(0); PG8_BAR; PG8_MMA(1, 0, At, B0); PG8_MMA(1, 1, At, B1); PG8_BAR; PG8_SCHED;
        }
        if (wr == 0) PG8_BAR;
        { int l2; asm volatile("v_mbcnt_lo_u32_b32 %0, -1, 0\n\tv_mbcnt_hi_u32_b32 %0, -1, %0" : "=v"(l2));
          E(acc, cur, wid >> 2, wid & 3, l2 & 15, l2 >> 4); }
        if (!has_next) break;
#pragma unroll
        for (int a = 0; a < 2; ++a)
#pragma unroll
            for (int b = 0; b < 2; ++b)
#pragma unroll
                for (int m = 0; m < 4; ++m)
#pragma unroll
                    for (int n = 0; n < 2; ++n) acc[a][b][m][n] = (f32x4){0.f, 0.f, 0.f, 0.f};
        cur = nxt; cA = nA; cB = nB; ++ui;
        if (wr == 1) PG8_BAR;
    }
    PG8_WAIT_V(0);
    PG8_BAR;
#undef PG8_SA
#undef PG8_SB
#undef PG8_STAGE_A
#undef PG8_GLDS
#undef PG8_SETVA
#undef PG8_SETVB
#undef PG8_STAGE_B
#undef PG8_LDA
#undef PG8_LDB
#undef PG8_MMA
#undef PG8_WAIT_V
#undef PG8_WAIT_L
#undef PG8_BAR
#undef PG8_SCHED
}

struct EpiBf16 {
    static constexpr bool PERM = true;
    bf16_t* O; int ldc; const LAS int* seg; int grouped; int nostore; float scale;
    __device__ __forceinline__ void operator()(const f32x4 (&acc)[2][2][4][2], const Unit& u, int wr, int wc, int fr, int fq) const {
        const int rbase = (grouped ? seg[u.e] : 0) + u.pm * BM + wr * 64 + fr;
        const int col0 = u.pn * BM + wc * 32 + 8 * fq;
#pragma unroll
        for (int ai = 0; ai < 2; ++ai)
#pragma unroll
            for (int m = 0; m < 4; ++m) { bf16_t* rowp = O + (size_t)(rbase + ai * HALF + m * 16) * ldc + col0;
#pragma unroll
                for (int bj = 0; bj < 2; ++bj) { const f32x4 v0 = acc[ai][bj][m][0] * scale, v1 = acc[ai][bj][m][1] * scale;
                    u32x4 w; w.x = cvt_pk_bf16(v0[0], v0[1]); w.y = cvt_pk_bf16(v0[2], v0[3]); w.z = cvt_pk_bf16(v1[0], v1[1]); w.w = cvt_pk_bf16(v1[2], v1[3]);
                    *(u32x4*)(rowp + bj * HALF) = w; } }
    }
};
struct EpiProj {
    static constexpr bool PERM = true;
    bf16_t* O; const float* sgun; const float* qn; const float* kn; const float* rope; LAS float* SS;
    __device__ __forceinline__ void operator()(f32x4 (&acc)[2][2][4][2], const Unit& u, int wr, int wc, int fr, int fq) const {
        const int type = u.pn >> 2;
#if WIN_FP8
#pragma unroll
        for (int ai = 0; ai < 2; ++ai)
#pragma unroll
            for (int bj = 0; bj < 2; ++bj)
#pragma unroll
                for (int m = 0; m < 4; ++m)
#pragma unroll
                    for (int n = 0; n < 2; ++n) acc[ai][bj][m][n] = acc[ai][bj][m][n] * (1.0f / (ASC_H * WSC_GU));
#endif
        const int row0 = wr * 64 + fr;
        const int col0 = u.pn * BM + wc * 32 + 8 * fq;
        if (type == 0 || type == 1) {
#pragma unroll
            for (int ai = 0; ai < 2; ++ai)
#pragma unroll
                for (int bj = 0; bj < 2; ++bj)
#pragma unroll
                    for (int m = 0; m < 4; ++m)
#pragma unroll
                        for (int n = 0; n < 2; ++n) { const f32x4 v = acc[ai][bj][m][n]; const f32x2 a = gelu_pk((f32x2){v[0], v[1]}), b = gelu_pk((f32x2){v[2], v[3]}); acc[ai][bj][m][n] = (f32x4){a.x, a.y, b.x, b.y}; }
        }
        if (type >= 1 && type <= 3) {
            const int lane = fr + 16 * fq;
#pragma unroll
            for (int ai = 0; ai < 2; ++ai)
#pragma unroll
                for (int m = 0; m < 4; ++m)
#pragma unroll
                    for (int bj = 0; bj < 2; ++bj) { float ss = 0.f;
#pragma unroll
                        for (int n = 0; n < 2; ++n) { const f32x4 v = acc[ai][bj][m][n]; ss += (v[0] * v[0] + v[1] * v[1]) + (v[2] * v[2] + v[3] * v[3]); }
                        ss += shx(ss, 16, lane); ss += shx(ss, 32, lane);
                        if (fq == 0) SS[((ai * HALF + m * 16 + row0) * 2 + bj) * 4 + wc] = ss; }
            asm volatile("s_waitcnt lgkmcnt(0)" ::: "memory"); __builtin_amdgcn_s_barrier(); asm volatile("" ::: "memory");
            f32x4 gv[2][2];
#pragma unroll
            for (int bj = 0; bj < 2; ++bj)
#pragma unroll
                for (int n = 0; n < 2; ++n) gv[bj][n] = (type == 1) ? *(const f32x4*)(sgun + (col0 - 1024) + bj * HALF + 4 * n) : *(const f32x4*)((type == 2 ? qn : kn) + wc * 32 + 8 * fq + 4 * n);
#pragma unroll
            for (int ai = 0; ai < 2; ++ai)
#pragma unroll
                for (int m = 0; m < 4; ++m) { const int rt = ai * HALF + m * 16 + row0;
#pragma unroll
                    for (int bj = 0; bj < 2; ++bj) { const f32x4 p = *(const LAS f32x4*)(SS + (rt * 2 + bj) * 4);
                        const float rstd = rsqrtf(((p[0] + p[1]) + (p[2] + p[3])) * (1.0f / 128.0f) + NEPS);
#pragma unroll
                        for (int n = 0; n < 2; ++n) acc[ai][bj][m][n] = acc[ai][bj][m][n] * rstd * gv[bj][n]; }
                    if (type >= 2 && wc == 0) {
                        unsigned long long ro = (unsigned)(rt * 32 + 16 * (fq & 1)); asm volatile("" : "+v"(ro));
                        const float* rp = (rope + (size_t)u.pm * (BM * 32)) + ro;
                        const f32x4 c0 = *(const f32x4*)rp, c1 = *(const f32x4*)(rp + 4), c2 = *(const f32x4*)(rp + 8), c3 = *(const f32x4*)(rp + 12);
                        const float cs[8] = {c0[0], c0[2], c1[0], c1[2], c2[0], c2[2], c3[0], c3[2]}, sn[8] = {c0[1], c0[3], c1[1], c1[3], c2[1], c2[3], c3[1], c3[3]};
                        const float sg = (fq < 2) ? -1.0f : 1.0f;
#pragma unroll
                        for (int bj = 0; bj < 2; ++bj)
#pragma unroll
                            for (int n = 0; n < 2; ++n)
#pragma unroll
                                for (int j = 0; j < 4; ++j) { const float x = acc[ai][bj][m][n][j]; const float o = shx(x, 32, lane); acc[ai][bj][m][n][j] = x * cs[4 * n + j] + sg * o * sn[4 * n + j]; }
                    } }
        }
#pragma unroll
        for (int ai = 0; ai < 2; ++ai)
#pragma unroll
            for (int m = 0; m < 4; ++m) { bf16_t* rowp = (O + (size_t)u.pm * (BM * DIN) + u.pn * BM) + (unsigned)((ai * HALF + m * 16 + row0) * DIN + wc * 32 + 8 * fq);
#pragma unroll
                for (int bj = 0; bj < 2; ++bj) { const f32x4 v0 = acc[ai][bj][m][0], v1 = acc[ai][bj][m][1];
                    u32x4 w; w.x = cvt_pk_bf16(v0[0], v0[1]); w.y = cvt_pk_bf16(v0[2], v0[3]); w.z = cvt_pk_bf16(v1[0], v1[1]); w.w = cvt_pk_bf16(v1[2], v1[3]);
                    *(u32x4*)(rowp + bj * HALF) = w; } }
    }
};
struct EpiY8 {
    static constexpr bool PERM = true;
    unsigned char* O; const LAS int* seg;
    __device__ __forceinline__ void operator()(const f32x4 (&acc)[2][2][4][2], const Unit& u, int wr, int wc, int fr, int fq) const {
        constexpr float scale = YSC / (ASC_HID * WSC_D);
        const int rbase = seg[u.e] + u.pm * BM + wr * 64 + fr;
        const int col0 = u.pn * BM + wc * 32 + 8 * fq;
#pragma unroll
        for (int ai = 0; ai < 2; ++ai)
#pragma unroll
            for (int m = 0; m < 4; ++m) { unsigned char* rowp = O + (size_t)(rbase + ai * HALF + m * 16) * DM + col0;
#pragma unroll
                for (int bj = 0; bj < 2; ++bj) { const f32x4 v0 = acc[ai][bj][m][0] * scale, v1 = acc[ai][bj][m][1] * scale;
                    u32x2 w; w.x = pk4_fp8(v0[0], v0[1], v0[2], v0[3]); w.y = pk4_fp8(v1[0], v1[1], v1[2], v1[3]);
                    *(u32x2*)(rowp + bj * HALF) = w; } }
    }
};
struct EpiGateUp {
    static constexpr bool PERM = true;
    unsigned char* O; const LAS int* seg; int nostore;
    __device__ __forceinline__ void operator()(const f32x4 (&acc)[2][2][4][2], const Unit& u, int wr, int wc, int fr, int fq) const {
        if (nostore == 1) return;
        const int rbase = seg[u.e] + u.pm * BM + wr * 64 + fr;
        const int col0 = u.pn * HALF + wc * 32 + 8 * fq;
        constexpr float sg = 1.0f / (ASC_H * WSC_GU);
#pragma unroll
        for (int ai = 0; ai < 2; ++ai)
#pragma unroll
            for (int m = 0; m < 4; ++m) { unsigned char* rowp = O + (size_t)(rbase + ai * HALF + m * 16) * 512 + col0;
                float h[8];
#pragma unroll
                for (int n = 0; n < 2; ++n)
#pragma unroll
                    for (int j = 0; j < 4; ++j) h[4 * n + j] = silu1(acc[ai][0][m][n][j] * sg) * (acc[ai][1][m][n][j] * (sg * ASC_HID));
                u32x2 w; w.x = pk4_fp8(h[0], h[1], h[2], h[3]); w.y = pk4_fp8(h[4], h[5], h[6], h[7]);
                if (nostore == 2) { asm volatile("" :: "v"(w.x), "v"(w.y)); } else *(u32x2*)rowp = w; }
    }
};
struct EpiDelta {
    static constexpr bool PERM = true;
    bf16_t* O; const float* g; float scale;
    __device__ __forceinline__ void operator()(const f32x4 (&acc)[2][2][4][2], const Unit& u, int wr, int wc, int fr, int fq) const {
        const int row0 = u.pm * BM + wr * 64 + fr, col0 = u.pn * BM + wc * 32 + 8 * fq;
        f32x4 gv[2][2];
#pragma unroll
        for (int bj = 0; bj < 2; ++bj)
#pragma unroll
            for (int n = 0; n < 2; ++n) gv[bj][n] = *(const f32x4*)(g + col0 + bj * HALF + 4 * n) * scale;
#pragma unroll
        for (int ai = 0; ai < 2; ++ai)
#pragma unroll
            for (int m = 0; m < 4; ++m) { bf16_t* rowp = O + (size_t)(row0 + ai * HALF + m * 16) * DM + col0;
#pragma unroll
                for (int bj = 0; bj < 2; ++bj) { const f32x4 v0 = acc[ai][bj][m][0] * gv[bj][0], v1 = acc[ai][bj][m][1] * gv[bj][1];
                    u32x4 w; w.x = cvt_pk_bf16(v0[0], v0[1]); w.y = cvt_pk_bf16(v0[2], v0[3]); w.z = cvt_pk_bf16(v1[0], v1[1]); w.w = cvt_pk_bf16(v1[2], v1[3]);
                    *(u32x4*)(rowp + bj * HALF) = w; } }
    }
};
}

struct Args { const float* in[23]; float* out; unsigned char* ws; int ph_lo, ph_hi; };
enum { I_X = 0, I_C, I_ADAW, I_ADAB, I_MIXN, I_WIN, I_SGUN, I_SGUW, I_SGUB, I_QN, I_KN, I_ONS, I_ONA, I_WOUT, I_FFNN, I_RW, I_RB, I_EG, I_EU, I_ED, I_SG, I_SU, I_SD };

__device__ __forceinline__ void transpose_item(const float* W, int K, int N, bf16_t* WT, int kb, int nb, int dst_row0, LAS float* scr, int lane) {
    const int k0 = 64 * kb, n0 = 32 * nb;
#pragma unroll 8
    for (int i = 0; i < 32; ++i) { const int kk = 2 * i + (lane >> 5); scr[kk * 33 + (lane & 31)] = __builtin_nontemporal_load(&W[(size_t)(k0 + kk) * N + n0 + (lane & 31)]); }
    asm volatile("s_waitcnt lgkmcnt(0)" ::: "memory");
    const int c = lane & 7;
#pragma unroll
    for (int j = 0; j < 4; ++j) { const int n = (lane >> 3) + 8 * j; const LAS float* s = scr + (8 * c) * 33 + n;
        u32x4 o; o.x = cvt_pk_bf16(s[0 * 33], s[1 * 33]); o.y = cvt_pk_bf16(s[2 * 33], s[3 * 33]); o.z = cvt_pk_bf16(s[4 * 33], s[5 * 33]); o.w = cvt_pk_bf16(s[6 * 33], s[7 * 33]);
        *(u32x4*)(WT + (size_t)(dst_row0 + n) * K + k0 + 8 * c) = o; }
    asm volatile("s_waitcnt lgkmcnt(0)" ::: "memory");
}

__device__ __forceinline__ void transpose_item8(const float* W, int K, int N, unsigned char* WT, int kb, int nb, int dst_row0, float scale, LAS float* scr, int lane) {
    const int k0 = 128 * kb, n0 = 32 * nb;
#pragma unroll 8
    for (int i = 0; i < 64; ++i) { const int kk = 2 * i + (lane >> 5); scr[kk * 33 + (lane & 31)] = __builtin_nontemporal_load(&W[(size_t)(k0 + kk) * N + n0 + (lane & 31)]); }
    asm volatile("s_waitcnt lgkmcnt(0)" ::: "memory");
    const int c = lane & 7;
#pragma unroll
    for (int j = 0; j < 4; ++j) { const int n = (lane >> 3) + 8 * j; const LAS float* s = scr + (16 * c) * 33 + n;
        u32x4 o; o.x = pk4_fp8(s[0 * 33] * scale, s[1 * 33] * scale, s[2 * 33] * scale, s[3 * 33] * scale); o.y = pk4_fp8(s[4 * 33] * scale, s[5 * 33] * scale, s[6 * 33] * scale, s[7 * 33] * scale);
        o.z = pk4_fp8(s[8 * 33] * scale, s[9 * 33] * scale, s[10 * 33] * scale, s[11 * 33] * scale); o.w = pk4_fp8(s[12 * 33] * scale, s[13 * 33] * scale, s[14 * 33] * scale, s[15 * 33] * scale);
        *(u32x4*)(WT + (size_t)(dst_row0 + n) * K + k0 + 16 * c) = o; }
    asm volatile("s_waitcnt lgkmcnt(0)" ::: "memory");
}

__device__ __forceinline__ void phase_prologue(const Args& a, LAS unsigned char* lds, int tid, int wave, int lane) {
    const int G = gridDim.x, gw = blockIdx.x * NWAVES + wave, NGW = G * NWAVES;
    const size_t gt = (size_t)blockIdx.x * NTHREADS + tid, NGT = (size_t)G * NTHREADS;
    unsigned char* ws = a.ws;
    {
        float* modp = (float*)(ws + WS_MODP);
        for (int u = gw; u < 2 * 16 * 48; u += NGW) {
            const int l = u / 768, r = u % 768, kc = r / 48, cc = r % 48;
            const float* w = a.in[I_ADAW] + ((size_t)l * DM + kc * 128) * 12288 + cc * 256 + 4 * lane;
            const float* cv = a.in[I_C] + kc * 128;
            f32x4 s = {0.f, 0.f, 0.f, 0.f};
#pragma unroll 8
            for (int k = 0; k < 128; ++k) { const float cvk = cv[k]; const float cd = cvk / (1.0f + __expf(-cvk)); const f32x4 wv = __builtin_nontemporal_load((const f32x4*)(w + (size_t)k * 12288)); s += wv * cd; }
            *(f32x4*)(modp + ((size_t)kc * 2 + l) * 12288 + cc * 256 + 4 * lane) = s;
        }
    }
    {
        float* rope = (float*)(ws + WS_ROPE);
        for (size_t i = gt; i < (size_t)SEQ * 16; i += NGT) {
            const int pos = (int)(i >> 4), f = (int)(i & 15);
            const float inv = (float)exp2(-(double)f * (1.0 / 16.0) * 18.931568569324174);
            const float ang = (float)pos * inv;
            double rev = (double)ang * 0.15915494309189535; rev -= rint(rev);
            rope[2 * i] = __builtin_amdgcn_cosf((float)rev); rope[2 * i + 1] = __builtin_amdgcn_sinf((float)rev);
        }
    }
    {
        bf16_t* sg = (bf16_t*)(ws + WS_SGUW);
        for (size_t i = gt; i < (size_t)2 * 8 * 128 * 128; i += NGT) { const int jj = (int)(i & 127), ii = (int)((i >> 7) & 127); const float v = a.in[I_SGUW][i];
            sg[(i & ~(size_t)127) + (size_t)((jj & ~31) + 8 * (jj & 3) + ((jj >> 2) & 7))] = (bf16_t)(cvt_pk_bf16(jj <= ii ? v : 0.f, 0.f) & 0xffffu); }
        bf16_t* rt = (bf16_t*)(ws + WS_RT);
        for (size_t i = gt; i < (size_t)2 * 2048 * 64; i += NGT) { const int l = (int)(i >> 17), r = (int)(i & 131071), k = r >> 6, e = r & 63; const float v = a.in[I_RW][i];
            const unsigned hi = cvt_pk_bf16(v, 0.f) & 0xffffu; const float lo = v - __uint_as_float(hi << 16);
            const int fo = ((((k >> 5) * 4 + (e >> 4)) * 64 + ((k >> 3) & 3) * 16 + (e & 15)) << 3) + (k & 7);
            rt[(size_t)l * 262144 + fo] = (bf16_t)hi; rt[(size_t)l * 262144 + 131072 + fo] = (bf16_t)(cvt_pk_bf16(lo, 0.f) & 0xffffu); }
    }
    {
        LAS float* scr = (LAS float*)(lds + wave * 17408);
#if WIN_FP8
        constexpr int I_WIN_ITEMS = 16 * 160;
#else
        constexpr int I_WIN_ITEMS = 32 * 160;
#endif
#if WOUT_FP8
        constexpr int I_WOUT_ITEMS = 16 * 64;
#else
        constexpr int I_WOUT_ITEMS = 32 * 64;
#endif
        constexpr int PER_LAYER = I_WIN_ITEMS + I_WOUT_ITEMS + 65 * 768;
        for (int it = gw; it < 2 * PER_LAYER; it += NGW) {
            const int l = it / PER_LAYER; int r = it % PER_LAYER;
            unsigned char* wl = ws + WS_W + (size_t)l * W_LAYER;
            if (r < I_WIN_ITEMS) {
#if WIN_FP8
                transpose_item8(a.in[I_WIN] + (size_t)l * DM * DIN, DM, DIN, wl + W_IN, r / 160, r % 160, 32 * (r % 160), WSC_GU, scr, lane);
#else
                transpose_item(a.in[I_WIN] + (size_t)l * DM * DIN, DM, DIN, (bf16_t*)(wl + W_IN), r / 160, r % 160, 32 * (r % 160), scr, lane);
#endif
                continue; }
            r -= I_WIN_ITEMS;
            if (r < I_WOUT_ITEMS) {
#if WOUT_FP8
                transpose_item8(a.in[I_WOUT] + (size_t)l * DM * DM, DM, DM, wl + W_OUT, r / 64, r % 64, 32 * (r % 64), WSC_GU, scr, lane);
#else
                transpose_item(a.in[I_WOUT] + (size_t)l * DM * DM, DM, DM, (bf16_t*)(wl + W_OUT), r / 64, r % 64, 32 * (r % 64), scr, lane);
#endif
                continue; }
            r -= I_WOUT_ITEMS;
            const int e = r / 768, q = r % 768, which = q / 256, s = q % 256;
            if (which < 2) {
                const float* src = (e < 64) ? a.in[which == 0 ? I_EG : I_EU] + ((size_t)l * 64 + e) * (size_t)DM * 512 : a.in[which == 0 ? I_SG : I_SU] + (size_t)l * DM * 512;
                const int kb = s / 16, nb = s % 16, n0 = 32 * nb;
                transpose_item8(src, DM, 512, wl + W_GU + (size_t)e * 2 * MiB, kb, nb, 256 * (n0 >> 7) + 128 * which + (n0 & 127), WSC_GU, scr, lane);
            } else {
                const float* src = (e < 64) ? a.in[I_ED] + ((size_t)l * 64 + e) * (size_t)512 * DM : a.in[I_SD] + (size_t)l * 512 * DM;
                const int kb = s / 64, nb = s % 64;
                transpose_item8(src, 512, DM, wl + W_D + (size_t)e * 1 * MiB, kb, nb, 32 * nb, WSC_D, scr, lane);
            }
        }
    }
}

__device__ __forceinline__ void phase_modreduce(const Args& a, int tid) {
    const float* modp = (const float*)(a.ws + WS_MODP); float* mod = (float*)(a.ws + WS_CTL) + CW_MOD;
    for (int i = blockIdx.x * NTHREADS + tid; i < 2 * 12288; i += gridDim.x * NTHREADS) { float s = a.in[I_ADAB][i];
#pragma unroll
        for (int kc = 0; kc < 16; ++kc) s += modp[(size_t)kc * 24576 + i];
        mod[i] = s; }
}

__device__ __forceinline__ void load_row(const float* row, int lane, f32x4 (&v)[8]) {
#pragma unroll
    for (int j = 0; j < 4; ++j) { const f32x4* p = (const f32x4*)(row + 8 * (64 * j + lane)); v[2 * j] = p[0]; v[2 * j + 1] = p[1]; }
}
__device__ __forceinline__ void add_row_bf16(const bf16_t* row, int lane, f32x4 (&v)[8]) {
#pragma unroll
    for (int j = 0; j < 4; ++j) { float t[8]; unpack8(*(const u32x4*)(row + 8 * (64 * j + lane)), t);
        v[2 * j] += (f32x4){t[0], t[1], t[2], t[3]}; v[2 * j + 1] += (f32x4){t[4], t[5], t[6], t[7]}; }
}
__device__ __forceinline__ float sumsq8(const f32x4 (&v)[8]) { float s = 0.f;
#pragma unroll
    for (int j = 0; j < 8; ++j) s += (v[j][0] * v[j][0] + v[j][1] * v[j][1]) + (v[j][2] * v[j][2] + v[j][3] * v[j][3]);
    return s; }
__device__ __forceinline__ void load_mod_vecs(const float* gain, const float* sc, const float* sh, int lane, f32x4 (&ga)[8], f32x4 (&gb)[8]) {
    f32x4 g[8], s[8]; load_row(gain, lane, g); load_row(sc, lane, s); load_row(sh, lane, gb);
#pragma unroll
    for (int j = 0; j < 8; ++j) ga[j] = g[j] * (s[j] + 1.0f);
}
__device__ __forceinline__ void store_row_bf16(bf16_t* row, int lane, const f32x4 (&h)[8]) {
#pragma unroll
    for (int j = 0; j < 4; ++j) { u32x4 w; w.x = cvt_pk_bf16(h[2 * j][0], h[2 * j][1]); w.y = cvt_pk_bf16(h[2 * j][2], h[2 * j][3]); w.z = cvt_pk_bf16(h[2 * j + 1][0], h[2 * j + 1][1]); w.w = cvt_pk_bf16(h[2 * j + 1][2], h[2 * j + 1][3]);
        *(u32x4*)(row + 8 * (64 * j + lane)) = w; }
}

__device__ __forceinline__ void store_row_fp8(unsigned char* row, int lane, const f32x4 (&h)[8], float sc) {
#pragma unroll
    for (int j = 0; j < 4; ++j) { u32x2 w; w.x = pk4_fp8(h[2 * j][0] * sc, h[2 * j][1] * sc, h[2 * j][2] * sc, h[2 * j][3] * sc); w.y = pk4_fp8(h[2 * j + 1][0] * sc, h[2 * j + 1][1] * sc, h[2 * j + 1][2] * sc, h[2 * j + 1][3] * sc);
        *(u32x2*)(row + 8 * (64 * j + lane)) = w; }
}

__device__ __forceinline__ void phase_norm1(const Args& a, int l, const float* xin, int wave, int lane) {
    const int gw = blockIdx.x * NWAVES + wave, NGW = gridDim.x * NWAVES;
    const float* mod = (const float*)(a.ws + WS_CTL) + CW_MOD + l * 12288;
    bf16_t* H = (bf16_t*)(a.ws + WS_H);
    f32x4 ga[8], gb[8]; load_mod_vecs(a.in[I_MIXN] + l * DM, mod + 2048, mod + 0, lane, ga, gb);
    for (int m = gw; m < SEQ; m += NGW) {
        f32x4 v[8]; load_row(xin + (size_t)m * DM, lane, v);
        const float rstd = rsqrtf(wave_sum(sumsq8(v), lane) * (1.0f / DM) + NEPS);
#pragma unroll
        for (int j = 0; j < 8; ++j) v[j] = v[j] * rstd * ga[j] + gb[j];
#if WIN_FP8
        store_row_fp8((unsigned char*)H + (size_t)m * DM, lane, v, ASC_H);
#else
        store_row_bf16(H + (size_t)m * DM, lane, v);
#endif
    }
}

__device__ __forceinline__ void phase_post(const Args& a, int l, int wave, int lane, bool dummy) {
    const int gw = blockIdx.x * NWAVES + wave, NGW = gridDim.x * NWAVES;
    bf16_t* P = (bf16_t*)(a.ws + WS_PROJ);
    bf16_t* PD = dummy ? (bf16_t*)(a.ws + WS_DUMMY) : P;
    const float* rope = (const float*)(a.ws + WS_ROPE);
    const int c0 = 16 * lane;
    const int dim0 = (lane & 7) * 16;
    float gs[16], gq[16], gk[16];
#pragma unroll
    for (int j = 0; j < 16; ++j) { gs[j] = a.in[I_SGUN][l * 1024 + c0 + j]; gq[j] = a.in[I_QN][l * 128 + dim0 + j]; gk[j] = a.in[I_KN][l * 128 + dim0 + j]; }
    for (int m = gw; m < SEQ; m += NGW) {
        const bf16_t* row = P + (size_t)m * DIN; bf16_t* drow = PD + (size_t)m * DIN;
        { u32x4 w0 = *(const u32x4*)(row + c0), w1 = *(const u32x4*)(row + c0 + 8); float f[16]; { float t[8]; unpack8(w0, t);
#pragma unroll
              for (int j = 0; j < 8; ++j) f[j] = t[j]; unpack8(w1, t);
#pragma unroll
              for (int j = 0; j < 8; ++j) f[8 + j] = t[j]; }
#pragma unroll
          for (int j = 0; j < 16; ++j) f[j] = gelu1(f[j]);
          float t0[8], t1[8];
#pragma unroll
          for (int j = 0; j < 8; ++j) { t0[j] = f[j]; t1[j] = f[8 + j]; }
          *(u32x4*)(drow + c0) = pack8(t0); *(u32x4*)(drow + c0 + 8) = pack8(t1); }
        { u32x4 w0 = *(const u32x4*)(row + 1024 + c0), w1 = *(const u32x4*)(row + 1024 + c0 + 8); float f[16]; { float t[8]; unpack8(w0, t);
#pragma unroll
              for (int j = 0; j < 8; ++j) f[j] = t[j]; unpack8(w1, t);
#pragma unroll
              for (int j = 0; j < 8; ++j) f[8 + j] = t[j]; }
          float ss = 0.f;
#pragma unroll
          for (int j = 0; j < 16; ++j) { f[j] = gelu1(f[j]); ss += f[j] * f[j]; }
          ss += shx(ss, 1, lane); ss += shx(ss, 2, lane); ss += shx(ss, 4, lane);
          const float rstd = rsqrtf(ss * (1.0f / 128.0f) + NEPS);
          float t0[8], t1[8];
#pragma unroll
          for (int j = 0; j < 8; ++j) { t0[j] = f[j] * rstd * gs[j]; t1[j] = f[8 + j] * rstd * gs[8 + j]; }
          *(u32x4*)(drow + 1024 + c0) = pack8(t0); *(u32x4*)(drow + 1024 + c0 + 8) = pack8(t1); }
#pragma unroll
        for (int qk = 0; qk < 2; ++qk) {
            const bf16_t* p = row + 2048 + qk * 1024 + c0; bf16_t* dp = drow + 2048 + qk * 1024 + c0;
            u32x4 w0 = *(const u32x4*)p, w1 = *(const u32x4*)(p + 8); float f[16]; { float t[8]; unpack8(w0, t);
#pragma unroll
              for (int j = 0; j < 8; ++j) f[j] = t[j]; unpack8(w1, t);
#pragma unroll
              for (int j = 0; j < 8; ++j) f[8 + j] = t[j]; }
            float ss = 0.f;
#pragma unroll
            for (int j = 0; j < 16; ++j) ss += f[j] * f[j];
            ss += shx(ss, 1, lane); ss += shx(ss, 2, lane); ss += shx(ss, 4, lane);
            const float rstd = rsqrtf(ss * (1.0f / 128.0f) + NEPS);
#pragma unroll
            for (int j = 0; j < 16; ++j) f[j] = f[j] * rstd * (qk == 0 ? gq[j] : gk[j]);
            const int sub = lane & 7;
#pragma unroll
            for (int j = 0; j < 16; ++j) { const float other = shx(f[j], 1, lane);
                if (sub < 2) { const float cs = rope[((size_t)m * 16 + j) * 2], sn = rope[((size_t)m * 16 + j) * 2 + 1];
                    f[j] = (sub == 0) ? (f[j] * cs - other * sn) : (f[j] * cs + other * sn); } }
            float t0[8], t1[8];
#pragma unroll
            for (int j = 0; j < 8; ++j) { t0[j] = f[j]; t1[j] = f[8 + j]; }
            *(u32x4*)dp = pack8(t0); *(u32x4*)(dp + 8) = pack8(t1);
        }
    }
}

constexpr int TSTR = 288;
__device__ __forceinline__ void sgu_fetch(const Args& a, int uid, int tid, u32x4 (&pu)[4], u32x4 (&pv)[4]) {
    const int n = uid >> 3, g = uid & 7;
    const bf16_t* P = (const bf16_t*)(a.ws + WS_PROJ);
#pragma unroll
    for (int it = 0; it < 4; ++it) { const int c = tid + 512 * it, row = c >> 4, ch = c & 15;
        const bf16_t* src = P + (size_t)(128 * n + row) * DIN + 128 * g + 8 * ch;
        pu[it] = *(const u32x4*)src; pv[it] = *(const u32x4*)(src + 1024); }
}
__device__ __forceinline__ void sgu_unit(const Args& a, int l, LAS unsigned char* lds, int uid, int nuid, int tid, int wid, int lane, u32x4 (&pu)[4], u32x4 (&pv)[4]) {
    const int n = uid >> 3, g = uid & 7;
    bf16_t* YM = (bf16_t*)(a.ws + WS_YMIX);
    LAS unsigned char* LU = lds; LAS unsigned char* LV = lds + 128 * TSTR;
#pragma unroll
    for (int it = 0; it < 4; ++it) { const int c = tid + 512 * it, row = c >> 4, ch = c & 15;
        *(LAS u32x4*)(LU + row * TSTR + ch * 16) = pu[it];
        *(LAS u32x4*)(LV + row * TSTR + ch * 16) = pv[it]; }
    __syncthreads();
    if (nuid < 1024) sgu_fetch(a, nuid, tid, pu, pv);
    const int fr = lane & 15, kg = lane >> 4, q4 = fr >> 2, p4 = lane & 3;
    const bf16_t* W = (const bf16_t*)(a.ws + WS_SGUW) + ((size_t)(l * 8 + g) * 128 + 16 * wid + fr) * 128 + 8 * kg;
    bf16x8 af[4];
#pragma unroll
    for (int ks = 0; ks < 4; ++ks) af[ks] = *(const bf16x8*)(W + 32 * ks);
    f32x4 acc[8];
#pragma unroll
    for (int ct = 0; ct < 8; ++ct) { acc[ct] = (f32x4){0.f, 0.f, 0.f, 0.f};
#pragma unroll
        for (int ks = 0; ks < 4; ++ks) {
            unsigned vba = (unsigned)(size_t)(LV + (32 * ks + 8 * kg + q4) * TSTR + (16 * ct + 4 * p4) * 2); asm volatile("" : "+v"(vba));
            const LAS unsigned char* vb = (const LAS unsigned char*)(size_t)vba;
#if DIAG_NOTR
            bf16x8 bfr; (void)vb;
#pragma unroll
            for (int j = 0; j < 8; ++j) bfr[j] = (short)*(const LAS bf16_t*)(LV + (32 * ks + 4 * j + kg) * TSTR + (16 * ct + fr) * 2);
#else
            const bf16x8 bfr = cat4(lds_tr(vb), lds_tr(vb + 4 * TSTR));
#endif
#if !DIAG_NOTR
            asm volatile("s_waitcnt lgkmcnt(0)" ::: "memory");
#endif
            acc[ct] = __builtin_amdgcn_mfma_f32_16x16x32_bf16(af[ks], bfr, acc[ct], 0, 0, 0); } }
    float bsv[4], ss[4] = {0.f, 0.f, 0.f, 0.f};
#pragma unroll
    for (int r = 0; r < 4; ++r) bsv[r] = a.in[I_SGUB][(l * 8 + g) * 128 + 16 * wid + 4 * kg + r];
#pragma unroll
    for (int ct = 0; ct < 8; ++ct)
#pragma unroll
        for (int r = 0; r < 4; ++r) { const int i = 16 * wid + 4 * kg + r, c = 16 * ct + fr;
            const float u = bf2f(*(const LAS bf16_t*)(LU + i * TSTR + c * 2));
            const float y = u * (acc[ct][r] + bsv[r]); acc[ct][r] = y; ss[r] += y * y; }
#pragma unroll
    for (int r = 0; r < 4; ++r) { float s = ss[r]; s += shx(s, 1, lane); s += shx(s, 2, lane); s += shx(s, 4, lane); s += shx(s, 8, lane); ss[r] = rsqrtf(s * (1.0f / 128.0f) + NEPS); }
#pragma unroll
    for (int ct = 0; ct < 8; ++ct) { const int c = 16 * ct + fr; const float go = a.in[I_ONS][l * 1024 + 128 * g + c];
#pragma unroll
        for (int r = 0; r < 4; ++r) { const int i = 16 * wid + 4 * kg + r;
#if WOUT_FP8
            ((unsigned char*)YM)[(size_t)(128 * n + i) * DM + 128 * g + c] = (unsigned char)(pk4_fp8(acc[ct][r] * ss[r] * go * ASC_H, 0.f, 0.f, 0.f) & 0xffu);
#else
            YM[(size_t)(128 * n + i) * DM + 128 * g + c] = (bf16_t)(cvt_pk_bf16(acc[ct][r] * ss[r] * go, 0.f) & 0xffffu);
#endif
            } }
    __syncthreads();
}

__device__ __forceinline__ void glds16(const void* sbase, unsigned voff, unsigned ldsaddr) {
    unsigned keep; asm volatile("s_mov_b32 %0, m0\n\ts_mov_b32 m0, %3\n\ts_nop 0\n\tglobal_load_lds_dwordx4 %1, %2\n\ts_mov_b32 m0, %0" : "=&s"(keep) : "v"(voff), "s"(sbase), "s"(ldsaddr) : "memory");
}
struct AttnUnitDesc { int p, h, dsh, n, qbase, kbase; };
__device__ __forceinline__ AttnUnitDesc attn_desc(int uid) {
    AttnUnitDesc d; d.p = uid >> 10; const int rem = uid & 1023; d.h = rem >> 7; const int rn = rem & 127;
    d.dsh = 2 * d.p; const int nbsh = 7 - d.dsh; const int r = rn >> nbsh; d.n = rn & ((1 << nbsh) - 1);
    d.qbase = r + ((128 * d.n) << d.dsh); d.kbase = d.qbase - (128 << d.dsh); return d;
}
__device__ __forceinline__ void attn_issue(const bf16_t* P, const AttnUnitDesc& d, int which, unsigned ldsbase, int wid, int lane) {
    const int colbase = (which == 0 ? 3072 : 4096) + d.h * 128;
#pragma unroll
    for (int j = 0; j < 8; ++j) { const int piece = 8 * wid + j, row = 4 * piece + (lane >> 4), c = lane & 15;
        const int kj = (d.n == 0 && row < 128) ? row + 128 : row;
        const int pos = d.kbase + (kj << d.dsh);
        const unsigned voff = (unsigned)pos * (unsigned)(DIN * 2) + (unsigned)(colbase * 2) + (unsigned)((c ^ (which == 0 ? (row & 15) : 2 * (row & 7))) * 16);
        glds16(P, voff, ldsbase + (unsigned)(which * 65536 + piece * 1024)); }
}
__device__ __forceinline__ void attn_units(const Args& a, LAS unsigned char* lds, int first_uid, int tid, int wid, int lane) {
    const bf16_t* P = (const bf16_t*)(a.ws + WS_PROJ);
    bf16_t* ATT = (bf16_t*)(a.ws + WS_ATT);
    float* LSE = (float*)(a.ws + WS_LSE);
    const unsigned ldsbase = (unsigned)(size_t)lds;
    const int fr = lane & 15, kg = lane >> 4, q4 = fr >> 2, p4 = lane & 3;
    const int qi = 16 * wid + fr;
    int uid = first_uid;
    if (uid >= 3072) return;
    AttnUnitDesc d = attn_desc(uid);
#if ATT_PIPE
    attn_issue(P, d, 0, ldsbase, wid, lane); attn_issue(P, d, 1, ldsbase, wid, lane);
#endif
    bf16x8 qf[4];
    { const bf16_t* qrow = P + (size_t)(d.qbase + (qi << d.dsh)) * DIN + 2048 + d.h * 128 + 8 * kg;
#pragma unroll
      for (int ks = 0; ks < 4; ++ks) qf[ks] = *(const bf16x8*)(qrow + 32 * ks); }
    bool first = true;
    u32x2 pw[8]; bf16_t* porow = ATT; float* plsep = LSE; float plse = 0.f;
#pragma unroll
    for (int dt = 0; dt < 8; ++dt) pw[dt] = (u32x2){0u, 0u};
    for (;;) {
        const int nuid = uid + (int)gridDim.x; const bool has_next = nuid < 3072;
        AttnUnitDesc dn = d; if (has_next) dn = attn_desc(nuid);
#if !ATT_PIPE
        __syncthreads();
#if ATT_CLEAR
        for (int i = tid; i < 8192; i += NTHREADS) *(LAS u32x4*)(lds + 16 * i) = (u32x4){0u, 0u, 0u, 0u};
        asm volatile("s_waitcnt lgkmcnt(0)" ::: "memory"); __syncthreads();
#endif
#if ATT_VOLD
#pragma unroll
        for (int it = 0; it < 8; ++it) { const int c = tid + 512 * it, row = c >> 4, ch = c & 15;
            const int kj = (d.n == 0 && row < 128) ? row + 128 : row;
            const int pos = d.kbase + (kj << d.dsh);
            *(LAS u32x4*)(lds + row * TSTR + ch * 16) = *(const u32x4*)(P + (size_t)pos * DIN + 4096 + d.h * 128 + 8 * ch); }
#else
        attn_issue(P, d, 0, ldsbase, wid, lane); attn_issue(P, d, 1, ldsbase, wid, lane);
#endif
#endif
        if (first) asm volatile("s_waitcnt vmcnt(0)" ::: "memory"); else asm volatile("s_waitcnt vmcnt(8)" ::: "memory");
        __builtin_amdgcn_s_barrier(); asm volatile("" ::: "memory");
        if (!first) {
#pragma unroll
            for (int dt = 0; dt < 8; ++dt) *(u32x2*)(porow + 16 * dt) = pw[dt];
            if (kg == 0) *plsep = plse; }
        first = false;
        f32x4 s[10]; int mism = 0;
#pragma unroll
        for (int i = 0; i < 10; ++i) { const int T = (wid + i) < 15 ? (wid + i) : 15; const int row = 16 * T + fr;
            const LAS unsigned char* kb = lds + row * 256; const int sw = fr;
            f32x4 c4 = {0.f, 0.f, 0.f, 0.f};
#if ATT_KGLOBAL
            { const int kj0 = (d.n == 0 && row < 128) ? row + 128 : row; const bf16_t* krow = P + (size_t)(d.kbase + (kj0 << d.dsh)) * DIN + 3072 + d.h * 128 + 8 * kg;
#pragma unroll
              for (int ks = 0; ks < 4; ++ks) { const bf16x8 kgl = *(const bf16x8*)(krow + 32 * ks);
                  if (i == ATT_CHK_TILE) { const bf16x8 kld = *(const LAS bf16x8*)(kb + (((4 * ks + kg) ^ sw) * 16));
                      typedef int v4i __attribute__((ext_vector_type(4))); const v4i xa = __builtin_bit_cast(v4i, kgl), xb = __builtin_bit_cast(v4i, kld);
                      mism |= (xa[0] ^ xb[0]) | (xa[1] ^ xb[1]) | (xa[2] ^ xb[2]) | (xa[3] ^ xb[3]); }
                  c4 = __builtin_amdgcn_mfma_f32_16x16x32_bf16(kgl, qf[ks], c4, 0, 0, 0); } }
#else
            if (i < 9) {
#pragma unroll
                for (int ks = 0; ks < 4; ++ks) c4 = __builtin_amdgcn_mfma_f32_16x16x32_bf16(*(const LAS bf16x8*)(kb + (((4 * ks + kg) ^ sw) * 16)), qf[ks], c4, 0, 0, 0); }
#endif
            s[i] = c4; }
        asm volatile("s_waitcnt vmcnt(0) lgkmcnt(0)" ::: "memory"); __builtin_amdgcn_s_barrier(); asm volatile("" ::: "memory");
        if (has_next) {
#if ATT_PIPE
            attn_issue(P, dn, 0, ldsbase, wid, lane);
#endif
            const bf16_t* qrow = P + (size_t)(dn.qbase + (qi << dn.dsh)) * DIN + 2048 + dn.h * 128 + 8 * kg;
#pragma unroll
            for (int ks = 0; ks < 4; ++ks) qf[ks] = *(const bf16x8*)(qrow + 32 * ks); }
#if ATT_KGLOBAL
        if (__builtin_amdgcn_ballot_w64(mism != 0) != 0ull) { const unsigned long long t0 = __builtin_amdgcn_s_memrealtime(); while (__builtin_amdgcn_s_memrealtime() - t0 < 5000ull) __builtin_amdgcn_s_sleep(8); }
#endif
        const float sc = 0.08838834764831845f * 1.4426950408889634f;
        float mx = -INFINITY;
        int qim = qi; asm volatile("" : "+v"(qim));
#pragma unroll
        for (int i = 0; i < 10; ++i)
#pragma unroll
            for (int rg = 0; rg < 4; ++rg) { const int kj = 16 * (wid + i) + 4 * kg + rg, dist = qim + 128 - kj;
                const bool inwin = (i == 0) ? (dist <= 128) : (i == 8) ? (dist >= 0) : (i < 9);
                const bool valid = (wid + i <= 15) && inwin && (d.n > 0 || wid + i >= 8);
                const float v = valid ? s[i][rg] * sc : -INFINITY; s[i][rg] = v; mx = fmaxf(mx, v); }
        mx = fmaxf(mx, shx(mx, 16, lane)); mx = fmaxf(mx, shx(mx, 32, lane));
        float sum = 0.f;
#pragma unroll
        for (int i = 0; i < 10; ++i)
#pragma unroll
            for (int rg = 0; rg < 4; ++rg) { const float e = __builtin_amdgcn_exp2f(s[i][rg] - mx); s[i][rg] = e; sum += e; }
        sum += shx(sum, 16, lane); sum += shx(sum, 32, lane);
        bf16x8 pf[5];
#pragma unroll
        for (int ks = 0; ks < 5; ++ks) { u32x4 w; w.x = cvt_pk_bf16(s[2 * ks][0], s[2 * ks][1]); w.y = cvt_pk_bf16(s[2 * ks][2], s[2 * ks][3]); w.z = cvt_pk_bf16(s[2 * ks + 1][0], s[2 * ks + 1][1]); w.w = cvt_pk_bf16(s[2 * ks + 1][2], s[2 * ks + 1][3]);
            pf[ks] = __builtin_bit_cast(bf16x8, w); }
        f32x4 o[8];
#pragma unroll
        for (int dt = 0; dt < 8; ++dt) o[dt] = (f32x4){0.f, 0.f, 0.f, 0.f};
        const int swv = 2 * (4 * (kg & 1) + q4);
#define ATT_VADDR(ks_, a0_, a1_) do { const int T0_ = (wid + 2 * (ks_)) < 15 ? (wid + 2 * (ks_)) : 15, T1_ = (wid + 2 * (ks_) + 1) < 15 ? (wid + 2 * (ks_) + 1) : 15; \
            a0_ = (unsigned)(size_t)(lds + 65536 + (16 * T0_ + 4 * kg + q4) * 256 + 8 * (p4 & 1)); a1_ = (unsigned)(size_t)(lds + 65536 + (16 * T1_ + 4 * kg + q4) * 256 + 8 * (p4 & 1)); asm volatile("" : "+v"(a0_), "+v"(a1_)); } while (0)
        {
            unsigned a0, a1; ATT_VADDR(0, a0, a1);
            s16x4 na = lds_tr((const LAS unsigned char*)(size_t)a0 + ((((2 * 0) ^ swv) + (p4 >> 1)) * 16)), nb = lds_tr((const LAS unsigned char*)(size_t)a1 + ((((2 * 0) ^ swv) + (p4 >> 1)) * 16));
#pragma unroll
            for (int ks = 0; ks < 5; ++ks) {
#pragma unroll
                for (int dt = 0; dt < 8; ++dt) {
                    const s16x4 ca = na, cb = nb;
                    if (dt < 7) { const int co = (((2 * (dt + 1)) ^ swv) + (p4 >> 1)) * 16; na = lds_tr((const LAS unsigned char*)(size_t)a0 + co); nb = lds_tr((const LAS unsigned char*)(size_t)a1 + co); }
                    else if (ks < 4) { ATT_VADDR(ks + 1, a0, a1); const int co = (((2 * 0) ^ swv) + (p4 >> 1)) * 16; na = lds_tr((const LAS unsigned char*)(size_t)a0 + co); nb = lds_tr((const LAS unsigned char*)(size_t)a1 + co); }
                    o[dt] = __builtin_amdgcn_mfma_f32_16x16x32_bf16(cat4(ca, cb), pf[ks], o[dt], 0, 0, 0); } }
        }
#undef ATT_VADDR
        asm volatile("s_waitcnt lgkmcnt(0)" ::: "memory"); __builtin_amdgcn_s_barrier(); asm volatile("" ::: "memory");
        if (has_next) attn_issue(P, dn, 1, ldsbase, wid, lane);
        const float inv = 1.0f / sum; const int posq = d.qbase + (qi << d.dsh);
        porow = ATT + ((size_t)d.p * SEQ + posq) * 1024 + d.h * 128 + 4 * kg;
#pragma unroll
        for (int dt = 0; dt < 8; ++dt) { pw[dt].x = cvt_pk_bf16(o[dt][0] * inv, o[dt][1] * inv); pw[dt].y = cvt_pk_bf16(o[dt][2] * inv, o[dt][3] * inv); }
        plsep = LSE + ((size_t)d.p * 8 + d.h) * SEQ + posq; plse = mx * 0.6931471805599453f + __logf(sum);
        if (!has_next) break;
        uid = nuid; d = dn;
    }
#pragma unroll
    for (int dt = 0; dt < 8; ++dt) *(u32x2*)(porow + 16 * dt) = pw[dt];
    if (kg == 0) *plsep = plse;
    asm volatile("s_waitcnt vmcnt(0)" ::: "memory"); __syncthreads();
}

__device__ __forceinline__ void phase_mix(const Args& a, int l, LAS unsigned char* lds, int tid, int wid, int lane) {
    { u32x4 pu[4], pv[4];
      if ((int)blockIdx.x < 1024) sgu_fetch(a, (int)blockIdx.x, tid, pu, pv);
#pragma unroll 1
      for (int uid = blockIdx.x; uid < 1024; uid += gridDim.x) sgu_unit(a, l, lds, uid, uid + (int)gridDim.x, tid, wid, lane, pu, pv); }
    attn_units(a, lds, (int)blockIdx.x, tid, wid, lane);
}

__device__ __forceinline__ void phase_attcomb(const Args& a, int l, int wave, int lane) {
    const int gw = blockIdx.x * NWAVES + wave, NGW = gridDim.x * NWAVES;
    const bf16_t* ATT = (const bf16_t*)(a.ws + WS_ATT);
    const float* LSE = (const float*)(a.ws + WS_LSE);
    bf16_t* YM = (bf16_t*)(a.ws + WS_YMIX);
    const int h = lane >> 3, c0 = 16 * lane;
    float gn[16];
#pragma unroll
    for (int j = 0; j < 16; ++j) gn[j] = a.in[I_ONA][l * 1024 + c0 + j];
    for (int m = gw; m < SEQ; m += NGW) {
        float ls[3], o[16];
#pragma unroll
        for (int p = 0; p < 3; ++p) ls[p] = LSE[((size_t)p * 8 + h) * SEQ + m];
        const float mxl = fmaxf(ls[0], fmaxf(ls[1], ls[2]));
        float al[3], asum = 0.f;
#pragma unroll
        for (int p = 0; p < 3; ++p) { al[p] = __expf(ls[p] - mxl); asum += al[p]; }
        const float ainv = 1.0f / asum;
#pragma unroll
        for (int j = 0; j < 16; ++j) o[j] = 0.f;
#pragma unroll
        for (int p = 0; p < 3; ++p) { const bf16_t* src = ATT + ((size_t)p * SEQ + m) * 1024 + c0; float t[8]; const float w = al[p] * ainv;
            unpack8(*(const u32x4*)src, t);
#pragma unroll
            for (int j = 0; j < 8; ++j) o[j] += w * t[j];
            unpack8(*(const u32x4*)(src + 8), t);
#pragma unroll
            for (int j = 0; j < 8; ++j) o[8 + j] += w * t[j]; }
        float ss = 0.f;
#pragma unroll
        for (int j = 0; j < 16; ++j) ss += o[j] * o[j];
        ss += shx(ss, 1, lane); ss += shx(ss, 2, lane); ss += shx(ss, 4, lane);
        const float rstd = rsqrtf(ss * (1.0f / 128.0f) + NEPS);
        float t0[8], t1[8];
#pragma unroll
        for (int j = 0; j < 8; ++j) { t0[j] = o[j] * rstd * gn[j]; t1[j] = o[8 + j] * rstd * gn[8 + j]; }
#if WOUT_FP8
        { u32x4 w; w.x = pk4_fp8(t0[0] * ASC_H, t0[1] * ASC_H, t0[2] * ASC_H, t0[3] * ASC_H); w.y = pk4_fp8(t0[4] * ASC_H, t0[5] * ASC_H, t0[6] * ASC_H, t0[7] * ASC_H);
          w.z = pk4_fp8(t1[0] * ASC_H, t1[1] * ASC_H, t1[2] * ASC_H, t1[3] * ASC_H); w.w = pk4_fp8(t1[4] * ASC_H, t1[5] * ASC_H, t1[6] * ASC_H, t1[7] * ASC_H);
          *(u32x4*)((unsigned char*)YM + (size_t)m * DM + 1024 + c0) = w; }
#else
        bf16_t* dst = YM + (size_t)m * DM + 1024 + c0;
        *(u32x4*)dst = pack8(t0); *(u32x4*)(dst + 8) = pack8(t1);
#endif
    }
}

constexpr int RSTR = 4112;
__device__ __forceinline__ void phase_router(const Args& a, int l, LAS unsigned char* lds, int tid, int wid, int lane, bool dummy) {
    const float* mod = (const float*)(a.ws + WS_CTL) + CW_MOD + l * 12288;
    const bf16_t* XB = (const bf16_t*)(a.ws + WS_XB); bf16_t* XR = (bf16_t*)(a.ws + (dummy ? WS_DUMMY + 192 * MiB : WS_XR));
    const bf16_t* MD = (const bf16_t*)(a.ws + WS_MIXD);
    unsigned char* H8 = a.ws + (dummy ? WS_DUMMY : WS_H);
    LAS unsigned char* HHI = lds;
    const bf16_t* RTH = (const bf16_t*)(a.ws + WS_RT) + (size_t)l * 262144; const bf16_t* RTL = RTH + 131072;
    unsigned* cnt = (unsigned*)(a.ws + WS_CTL) + CW_CNT + 64 * (l * 64) + (dummy ? 64 * 128 : 0);
    const size_t doff = dummy ? (WS_DUMMY + 64 * MiB - WS_TOKLIST) : 0;
    int* toklist = (int*)(a.ws + doff + WS_TOKLIST); int* toksel = (int*)(a.ws + doff + WS_TOKSEL); float* gwt = (float*)(a.ws + doff + WS_GW);
    f32x4 ga[8], gb[8]; load_mod_vecs(a.in[I_FFNN] + l * DM, mod + 4 * 2048, mod + 3 * 2048, lane, ga, gb);
    const int fr = lane & 15, kg = lane >> 4;
    const float rbias = a.in[I_RB][l * 64 + lane];
    for (int tile = blockIdx.x; tile < SEQ / 32; tile += gridDim.x) {
#pragma unroll 1
        for (int rp = 0; rp < 2; ++rp) { const int r0 = 4 * wid + 2 * rp, m0 = 32 * tile + r0;
            f32x4 v[8], u[8];
            if (l == 0) { load_row(a.in[I_X] + (size_t)m0 * DM, lane, v); load_row(a.in[I_X] + (size_t)(m0 + 1) * DM, lane, u); }
            else {
#pragma unroll
                for (int j = 0; j < 8; ++j) { v[j] = (f32x4){0.f, 0.f, 0.f, 0.f}; u[j] = (f32x4){0.f, 0.f, 0.f, 0.f}; }
                add_row_bf16(XB + (size_t)m0 * DM, lane, v); add_row_bf16(XB + (size_t)(m0 + 1) * DM, lane, u); }
            add_row_bf16(MD + (size_t)m0 * DM, lane, v); add_row_bf16(MD + (size_t)(m0 + 1) * DM, lane, u);
            store_row_bf16(XR + (size_t)m0 * DM, lane, v); store_row_bf16(XR + (size_t)(m0 + 1) * DM, lane, u);
            const float rstd0 = rsqrtf(wave_sum(sumsq8(v), lane) * (1.0f / DM) + NEPS), rstd1 = rsqrtf(wave_sum(sumsq8(u), lane) * (1.0f / DM) + NEPS);
#pragma unroll
            for (int j = 0; j < 8; ++j) { v[j] = v[j] * rstd0 * ga[j] + gb[j]; u[j] = u[j] * rstd1 * ga[j] + gb[j]; }
            store_row_fp8(H8 + (size_t)m0 * DM, lane, v, ASC_H); store_row_fp8(H8 + (size_t)(m0 + 1) * DM, lane, u, ASC_H);
#pragma unroll
            for (int j = 0; j < 4; ++j) { const float f[8] = {v[2 * j][0], v[2 * j][1], v[2 * j][2], v[2 * j][3], v[2 * j + 1][0], v[2 * j + 1][1], v[2 * j + 1][2], v[2 * j + 1][3]};
                *(LAS u32x4*)(HHI + r0 * RSTR + 16 * (64 * j + lane)) = pack8(f);
                const float g[8] = {u[2 * j][0], u[2 * j][1], u[2 * j][2], u[2 * j][3], u[2 * j + 1][0], u[2 * j + 1][1], u[2 * j + 1][2], u[2 * j + 1][3]};
                *(LAS u32x4*)(HHI + (r0 + 1) * RSTR + 16 * (64 * j + lane)) = pack8(g); } }
        __syncthreads();
        {
            f32x4 acc[2][4];
#pragma unroll
            for (int mt = 0; mt < 2; ++mt)
#pragma unroll
                for (int nt = 0; nt < 4; ++nt) acc[mt][nt] = (f32x4){0.f, 0.f, 0.f, 0.f};
#pragma unroll 2
            for (int ks = 0; ks < 8; ++ks) { const int k0 = 256 * wid + 32 * ks + 8 * kg;
                const bf16x8 a0 = *(const LAS bf16x8*)(HHI + fr * RSTR + k0 * 2), a1 = *(const LAS bf16x8*)(HHI + (16 + fr) * RSTR + k0 * 2);
#pragma unroll
                for (int nt = 0; nt < 4; ++nt) { const int fo = (((8 * wid + ks) * 4 + nt) * 64 + lane) << 3; const bf16x8 bh = *(const bf16x8*)(RTH + fo), bl = *(const bf16x8*)(RTL + fo);
                    acc[0][nt] = __builtin_amdgcn_mfma_f32_16x16x32_bf16(a0, bh, acc[0][nt], 0, 0, 0);
                    acc[0][nt] = __builtin_amdgcn_mfma_f32_16x16x32_bf16(a0, bl, acc[0][nt], 0, 0, 0);
                    acc[1][nt] = __builtin_amdgcn_mfma_f32_16x16x32_bf16(a1, bh, acc[1][nt], 0, 0, 0);
                    acc[1][nt] = __builtin_amdgcn_mfma_f32_16x16x32_bf16(a1, bl, acc[1][nt], 0, 0, 0); } }
            __syncthreads();
            LAS float* PART = (LAS float*)lds + wid * 2048;
#pragma unroll
            for (int mt = 0; mt < 2; ++mt)
#pragma unroll
                for (int nt = 0; nt < 4; ++nt)
#pragma unroll
                    for (int rg = 0; rg < 4; ++rg) PART[(16 * mt + 4 * kg + rg) * 64 + 16 * nt + fr] = acc[mt][nt][rg];
        }
        __syncthreads();
        LAS int* SCRI = (LAS int*)(lds + 65536 + wid * 2048); LAS float* SCRF = (LAS float*)(lds + 65536 + wid * 2048 + 1024);
#pragma unroll 1
        for (int rr = 0; rr < 4; ++rr) {
            const int tt = 4 * wid + rr, m = 32 * tile + tt;
            int ln = lane; asm volatile("" : "+v"(ln));
            float lgt = 0.f;
#pragma unroll
            for (int w = 0; w < 8; ++w) lgt += ((const LAS float*)lds)[w * 2048 + tt * 64 + lane];
            const float score = 1.0f / (1.0f + __expf(-lgt));
            const float sel = score + rbias;
            int r8 = 0;
#pragma unroll
            for (int j = 0; j < 8; ++j) { const float o = shl_f(sel, (lane & ~7) + j); r8 += ((o > sel) || (o == sel && j < (ln & 7))) ? 1 : 0; }
            float gs = (r8 < 2) ? sel : 0.f;
            gs += shx(gs, 1, lane); gs += shx(gs, 2, lane); gs += shx(gs, 4, lane);
            int rgp = 0;
#pragma unroll
            for (int j = 0; j < 8; ++j) { const float o = shl_f(gs, 8 * j); rgp += ((o > gs) || (o == gs && j < (ln >> 3))) ? 1 : 0; }
            const bool gsel = rgp < 4;
            const float msel = gsel ? sel : -INFINITY;
            int rk = 0;
#pragma unroll
            for (int j = 0; j < 64; ++j) { const float o = shl_f(msel, j); rk += ((o > msel) || (o == msel && j < ln)) ? 1 : 0; }
            const bool chosen = gsel && rk < 8;
            const float wsum = wave_sum(chosen ? score : 0.f, lane);
            (void)m; SCRI[rr * 64 + lane] = chosen ? rk : -1; SCRF[rr * 64 + lane] = score * (2.5f / wsum);
        }
        {
            int rkc[4]; float gwv[4];
#pragma unroll
            for (int rr = 0; rr < 4; ++rr) { rkc[rr] = SCRI[rr * 64 + lane]; gwv[rr] = SCRF[rr * 64 + lane]; }
            const int nsel = (rkc[0] >= 0 ? 1 : 0) + (rkc[1] >= 0 ? 1 : 0) + (rkc[2] >= 0 ? 1 : 0) + (rkc[3] >= 0 ? 1 : 0);
            unsigned base = 0u; if (nsel > 0) base = atomicAdd(cnt + 64 * lane, (unsigned)nsel);
            int run = 0;
#pragma unroll
            for (int rr = 0; rr < 4; ++rr) if (rkc[rr] >= 0) { const int m = 32 * tile + 4 * wid + rr, pos = (int)base + run; ++run;
                toklist[lane * SEQ + pos] = m; toksel[m * 8 + rkc[rr]] = lane * SEQ + pos; gwt[m * 8 + rkc[rr]] = gwv[rr]; }
        }
        __syncthreads();
    }
}

__device__ __forceinline__ void build_tables(const Args& a, int l, LAS unsigned char* lds, int tid) {
    LAS int* seg = (LAS int*)(lds + LDS_TAB); LAS int* xpre = (LAS int*)(lds + LDS_TAB + 512); LAS int* ntl = (LAS int*)(lds + LDS_TAB + 1024); LAS int* misc = (LAS int*)(lds + LDS_TAB + 1536);
    LAS int* cntl = (LAS int*)(lds + LDS_TOK) + TOK_CAP * 256;
#if GROUP_XCD == 0
    if (tid < 64) {
        const unsigned* cnt = (const unsigned*)(a.ws + WS_CTL) + CW_CNT + 64 * (l * 64);
        const int c = (int)__hip_atomic_load(cnt + 64 * tid, __ATOMIC_RELAXED, __HIP_MEMORY_SCOPE_AGENT); const int nt = (c + 255) >> 8;
        int incl = nt;
#pragma unroll
        for (int o = 1; o < 64; o <<= 1) { const int t = shl_i(incl, tid >= o ? tid - o : tid); if (tid >= o) incl += t; }
        seg[tid] = (incl - nt) * 256; ntl[tid] = nt; cntl[tid] = c; xpre[tid + 1] = incl;
        if (tid == 63) { seg[64] = incl * 256; xpre[65] = incl + 64; }
        if (tid == 0) { xpre[0] = 0; misc[0] = 1; misc[1] = 64; misc[2] = 0; }
    }
#else
    if (tid == 0) {
        const unsigned* cnt = (const unsigned*)(a.ws + WS_CTL) + CW_CNT + 64 * (l * 64);
        int s = 0;
        for (int e = 0; e < 64; ++e) { const int c = (int)__hip_atomic_load(cnt + 64 * e, __ATOMIC_RELAXED, __HIP_MEMORY_SCOPE_AGENT); const int nt = (c + 255) >> 8; seg[e] = s; ntl[e] = nt; cntl[e] = c; s += nt * 256; }
        seg[64] = s;
        const int G = gridDim.x, nv = (GROUP_XCD && G % 8 == 0) ? 8 : 1, nev = 64 / nv, v = (GROUP_XCD == 2) ? (int)blockIdx.x / (G / nv) : (int)blockIdx.x % nv;
        LAS int* rv = misc + 8; LAS int* sh = misc + 16;
        for (int x = 0; x < nv; ++x) { int t = 0; for (int k = 0; k < nev; ++k) t += ntl[x + nv * k]; rv[x] = t; sh[x] = 0; }
        for (int i = 0; i < 64; ++i) { int best = 0; for (int x = 1; x < nv; ++x) if (rv[x] + sh[x] < rv[best] + sh[best]) best = x; sh[best] += 1; }
        int st = 0; for (int x = 0; x < v; ++x) st += sh[x];
        int t = 0; xpre[0] = 0;
        for (int k = 0; k < nev; ++k) { t += ntl[v + nv * k]; xpre[k + 1] = t; }
        xpre[nev + 1] = t + sh[v];
        misc[0] = nv; misc[1] = nev; misc[2] = st;
    }
#endif
    __syncthreads();
}

__device__ __forceinline__ void phase_combine(const Args& a, int l, int wave, int lane, bool dummy) {
    const int gw = blockIdx.x * NWAVES + wave, NGW = gridDim.x * NWAVES;
    const float* mod = (const float*)(a.ws + WS_CTL) + CW_MOD + l * 12288;
    const unsigned char* Y = a.ws + WS_Y;
    const int* toksel = (const int*)(a.ws + WS_TOKSEL); const float* gwt = (const float*)(a.ws + WS_GW);
    const unsigned* cnt = (const unsigned*)(a.ws + WS_CTL) + CW_CNT + 64 * (l * 64);
    bf16_t* H = (bf16_t*)(a.ws + (dummy ? WS_DUMMY + 160 * MiB : WS_H));
    float* dout = dummy ? (float*)(a.ws + WS_DUMMY) : a.out;
    int myc = (((int)__hip_atomic_load(cnt + 64 * lane, __ATOMIC_RELAXED, __HIP_MEMORY_SCOPE_AGENT) + 255) >> 8) << 8, incl = myc;
#pragma unroll
    for (int o = 1; o < 64; o <<= 1) { const int t = shl_i(incl, lane >= o ? lane - o : lane); if (lane >= o) incl += t; }
    const int segstart = incl - myc; const int segsh = shl_i(incl, 63);
    f32x4 gf[8]; load_row(mod + 5 * 2048, lane, gf);
    f32x4 ga[8], gb[8];
    if (l == 0) { const float* mod1 = mod + 12288; load_mod_vecs(a.in[I_MIXN] + DM, mod1 + 2048, mod1, lane, ga, gb); }
    for (int m = gw; m < SEQ; m += NGW) {
        f32x4 v[8], yacc[8];
#pragma unroll
        for (int j = 0; j < 8; ++j) v[j] = (f32x4){0.f, 0.f, 0.f, 0.f};
        add_row_bf16((const bf16_t*)(a.ws + WS_XR) + (size_t)m * DM, lane, v);
#pragma unroll
        for (int j = 0; j < 8; ++j) yacc[j] = (f32x4){0.f, 0.f, 0.f, 0.f};
        int ts_l = 0; float w_l = 0.f;
        if (lane < 8) { ts_l = toksel[m * 8 + lane]; w_l = gwt[m * 8 + lane]; }
        const int slot_l = shl_i(segstart, ts_l >> 14) + (ts_l & 16383);
#pragma unroll 1
        for (int k0 = 0; k0 < 9; k0 += 3) {
            u32x2 q[3][4]; float wsc[3];
#pragma unroll
            for (int kk = 0; kk < 3; ++kk) { const int k = k0 + kk;
                const int slot = (k < 8) ? shl_i(slot_l, k) : segsh + m; const float w = (k < 8) ? shl_f(w_l, k) : 1.0f;
                const unsigned char* yr = Y + (size_t)slot * DM; wsc[kk] = w * (1.0f / YSC);
#pragma unroll
                for (int j = 0; j < 4; ++j) q[kk][j] = *(const u32x2*)(yr + 8 * (64 * j + lane)); }
#pragma unroll
            for (int kk = 0; kk < 3; ++kk) { const float ws = wsc[kk];
#pragma unroll
                for (int j = 0; j < 4; ++j) { const u32x2 qq = q[kk][j];
                    const f32x2 a0 = __builtin_amdgcn_cvt_pk_f32_fp8((int)qq.x, false), a1 = __builtin_amdgcn_cvt_pk_f32_fp8((int)qq.x, true), a2 = __builtin_amdgcn_cvt_pk_f32_fp8((int)qq.y, false), a3 = __builtin_amdgcn_cvt_pk_f32_fp8((int)qq.y, true);
                    yacc[2 * j] += (f32x4){a0.x, a0.y, a1.x, a1.y} * ws; yacc[2 * j + 1] += (f32x4){a2.x, a2.y, a3.x, a3.y} * ws; } }
        }
#pragma unroll
        for (int j = 0; j < 8; ++j) v[j] = v[j] + gf[j] * yacc[j];
        if (l == 0) store_row_bf16((bf16_t*)(a.ws + (dummy ? WS_DUMMY + 128 * MiB : WS_XB)) + (size_t)m * DM, lane, v);
        else {
#pragma unroll
            for (int j = 0; j < 4; ++j) { f32x4* p = (f32x4*)(dout + (size_t)m * DM + 8 * (64 * j + lane)); p[0] = v[2 * j]; p[1] = v[2 * j + 1]; } }
        if (l == 0) {
            const float rstd = rsqrtf(wave_sum(sumsq8(v), lane) * (1.0f / DM) + NEPS);
#pragma unroll
            for (int j = 0; j < 8; ++j) v[j] = v[j] * rstd * ga[j] + gb[j];
#if WIN_FP8
            store_row_fp8((unsigned char*)H + (size_t)m * DM, lane, v, ASC_H);
#else
            store_row_bf16(H + (size_t)m * DM, lane, v);
#endif
        }
    }
}

__device__ __forceinline__ Args fresh_args(const Args& a) {
    long z; asm volatile("s_mov_b64 %0, 0" : "=s"(z));
    Args r;
#pragma unroll
    for (int i = 0; i < 23; ++i) r.in[i] = a.in[i] + z;
    r.out = a.out + z; r.ws = a.ws + z;
    r.ph_lo = a.ph_lo; r.ph_hi = a.ph_hi; return r;
}
#if N_LAUNCH_MODE == 1
#define IN(k) true
#else
#define IN(k) (lo <= (k) && (k) < hi)
#endif
#ifndef PROBE_DUP
#define PROBE_DUP -1
#endif
#define REPS(j) _Pragma("unroll") for (int _rep = 0; _rep < ((PROBE_DUP == (j)) ? 2 : 1); ++_rep)
#define DUMMY(j) ((PROBE_DUP == (j)) && _rep == 0)
#define PBEGIN int ptid; asm volatile("v_mbcnt_lo_u32_b32 %0, -1, 0\n\tv_mbcnt_hi_u32_b32 %0, -1, %0" : "=v"(ptid)); ptid += wave * 64; const int plane = ptid & 63; const int pwave = __builtin_amdgcn_readfirstlane(ptid >> 6); (void)plane; (void)pwave; const Args pa = fresh_args(args); bf16_t* const H = (bf16_t*)(pa.ws + WS_H); bf16_t* const PROJ = (bf16_t*)(pa.ws + WS_PROJ); bf16_t* const YMIX = (bf16_t*)(pa.ws + WS_YMIX); bf16_t* const HID = (bf16_t*)(pa.ws + WS_HID); bf16_t* const Y = (bf16_t*)(pa.ws + WS_Y); unsigned char* const wl = pa.ws + WS_W + (size_t)lyr * W_LAYER; const float* const mod = (const float*)(pa.ws + WS_CTL) + CW_MOD + lyr * 12288; (void)H; (void)PROJ; (void)YMIX; (void)HID; (void)Y; (void)wl; (void)mod;
#define SEAM(k) do { if (IN(k) && IN((k) + 1)) { XcdBarrier b2 = bar; asm volatile("" : "+s"(b2.x)); xcd_barrier(b2); } } while (0)
template <int l>
__device__ __forceinline__ void layer_body(const Args& args, LAS unsigned char* lds, const XcdBarrier& bar, const int wave, const int G) {
    const int lo = args.ph_lo, hi = args.ph_hi; (void)lo; (void)hi;
    const int lyr = l;
        const int pb = 2 + 10 * l;
        if (IN(pb + 0)) REPS(0) { PBEGIN if (l == 0) phase_norm1(pa, 0, pa.in[I_X], pwave, plane); }
        if (l == 0) SEAM(pb + 0);
        if (IN(pb + 1)) REPS(1) { PBEGIN pg8::DenseSched S; S.init(H, wl + W_IN, SEQ, DIN, WIN_FP8 ? DM / 2 : DM, G, (int)blockIdx.x); pg8::EpiProj E{PROJ, pa.in[I_SGUN] + l * 1024, pa.in[I_QN] + l * 128, pa.in[I_KN] + l * 128, (const float*)(pa.ws + WS_ROPE), (LAS float*)(lds + LDS_TAB)};
            pg8::gemm_phase<pg8::EpiProj, pg8::DenseSched, 0, (WIN_FP8 != 0)>(lds, WIN_FP8 ? DM / 2 : DM, S, E, ptid); }
        SEAM(pb + 1);
        if (IN(pb + 3)) REPS(3) { PBEGIN phase_mix(pa, l, lds, ptid, pwave, plane); }
        SEAM(pb + 3);
        if (DIAG_STOP == 3 && l == 0) { PBEGIN const bf16_t* ATT = (const bf16_t*)(pa.ws + WS_ATT) + (size_t)DIAG_P * SEQ * 1024;
            for (size_t i = (size_t)blockIdx.x * NTHREADS + ptid; i < (size_t)SEQ * DM; i += (size_t)gridDim.x * NTHREADS) { const size_t m = i >> 11; const int c = (int)(i & 2047); pa.out[i] = (DIAG_SGU ? c < 1024 : false) ? bf2f(YMIX[m * DM + c]) : (c >= 1024 ? bf2f(ATT[m * 1024 + c - 1024]) : 0.f); }
            return; }
        if (IN(pb + 4)) REPS(4) { PBEGIN phase_attcomb(pa, l, pwave, plane); }
        SEAM(pb + 4);
        if (IN(pb + 5)) REPS(5) { PBEGIN pg8::DenseSched S; S.init(YMIX, wl + W_OUT, SEQ, DM, WOUT_FP8 ? DM / 2 : DM, G, (int)blockIdx.x); pg8::EpiDelta E{(bf16_t*)(pa.ws + (DUMMY(5) ? WS_DUMMY : WS_MIXD)), mod + 2 * 2048, WOUT_FP8 ? 1.0f / (ASC_H * WSC_GU) : 1.0f};
            pg8::gemm_phase<pg8::EpiDelta, pg8::DenseSched, 0, (WOUT_FP8 != 0)>(lds, WOUT_FP8 ? DM / 2 : DM, S, E, ptid); }
        SEAM(pb + 5);
        if (IN(pb + 6)) REPS(6) { PBEGIN phase_router(pa, l, lds, ptid, pwave, plane, DUMMY(6)); }
        SEAM(pb + 6);
        if (IN(pb + 7)) REPS(7) {
            PBEGIN
            build_tables(pa, l, lds, ptid);
            const LAS int* seg = (const LAS int*)(lds + LDS_TAB); LAS int* toks = (LAS int*)(lds + LDS_TOK);
            typedef pg8::GroupSched<DM / 2, 4, true> SchedGU; SchedGU S; S.init(lds, G, (int)blockIdx.x); S.A = (const char*)H; S.Bt = (const char*)(wl + W_GU); S.toks = toks; S.toklist = (const int*)(pa.ws + WS_TOKLIST);
            const unsigned* cnt = (const unsigned*)(pa.ws + WS_CTL) + CW_CNT + 64 * (l * 64); const int* toklist = (const int*)(pa.ws + WS_TOKLIST);
            { pg8::Unit u; const LAS int* cntl = (const LAS int*)(lds + LDS_TOK) + TOK_CAP * 256;
#pragma unroll 1
              for (int i = pwave; i < TOK_CAP; i += NWAVES) { if (!S.next(i, u)) break;
                  const int c = (u.e < 64) ? cntl[u.e] : SEQ;
#pragma unroll
                  for (int r = plane; r < 256; r += 64) { const int rr = u.pm * 256 + r; toks[i * 256 + r] = (rr < c) ? ((u.e < 64) ? toklist[u.e * SEQ + rr] : rr) : 0; } } }
            __syncthreads();
            pg8::EpiGateUp E{(unsigned char*)HID, seg, (PROBE_DUP == 7 && PROBE_NOSTORE && _rep == 0) ? PROBE_NOSTORE : 0};
            pg8::gemm_phase<pg8::EpiGateUp, SchedGU, STAG_GU, true>(lds, DM / 2, S, E, ptid);
        }
        SEAM(pb + 7);
        if (IN(pb + 8)) REPS(8) {
            PBEGIN
            build_tables(pa, l, lds, ptid);
            const LAS int* seg = (const LAS int*)(lds + LDS_TAB);
            typedef pg8::GroupSched<256, 8, false> SchedD; SchedD S; S.init(lds, G, (int)blockIdx.x); S.A = (const char*)HID; S.Bt = (const char*)(wl + W_D); S.toks = seg; S.toklist = nullptr;
            pg8::EpiY8 E{(unsigned char*)Y, seg};
            pg8::gemm_phase<pg8::EpiY8, SchedD, STAG_D, true>(lds, 256, S, E, ptid);
        }
        SEAM(pb + 8);
        if (IN(pb + 9)) REPS(9) { PBEGIN phase_combine(pa, l, pwave, plane, DUMMY(9)); }
        if (l == 0) SEAM(pb + 9);
}
constexpr int NPHASE = 22;
__global__ void __launch_bounds__(NTHREADS, 2) trunk_fwd(Args args) {
    extern __shared__ __attribute__((aligned(16))) unsigned char lds_raw[];
    LAS unsigned char* lds = (LAS unsigned char*)lds_raw;
    const int tid = threadIdx.x, lane = tid & 63, wave = __builtin_amdgcn_readfirstlane(tid >> 6);
    volatile LAS unsigned* MISC = (volatile LAS unsigned*)(lds + LDS_MISC);
    if (tid < 64) ((LAS unsigned*)(lds + LDS_MISC))[tid] = 0u;
    __syncthreads();
    unsigned* ctl = (unsigned*)(args.ws + WS_CTL);
    XcdBarrier bar = xcd_barrier_post(ctl + CW_BAR, MISC);
    const int lo = args.ph_lo, hi = args.ph_hi; (void)lo; (void)hi;
    const int G = gridDim.x;
    const int lyr = 0;

    if (IN(0)) REPS(100) { PBEGIN phase_prologue(pa, lds, ptid, pwave, plane); }
    SEAM(0);
    if (IN(1)) { PBEGIN phase_modreduce(pa, ptid); }
    SEAM(1);
    layer_body<0>(args, lds, bar, wave, G);
    if (DIAG_STOP >= 0) return;
    layer_body<1>(args, lds, bar, wave, G);
#undef IN
#undef SEAM
}

extern "C" void kernel_launch(void* const* d_in, const int* in_sizes, int n_in, void* d_out, int out_size, void* d_ws, size_t ws_size, hipStream_t stream) {
    static int grid = 0;
    if (grid == 0) {
        if (n_in != 23 || out_size != SEQ * DM || ws_size < WS_NEED) { fprintf(stderr, "kernel_launch: unexpected shapes (n_in %d, out %d, ws %zu < %zu)\n", n_in, out_size, ws_size, (size_t)WS_NEED); grid = -1; return; }
        int dev = 0, cus = 0, per_cu = 0;
        if (hipGetDevice(&dev) != hipSuccess || hipDeviceGetAttribute(&cus, hipDeviceAttributeMultiprocessorCount, dev) != hipSuccess) { grid = -1; return; }
        if (hipFuncSetAttribute((const void*)trunk_fwd, hipFuncAttributeMaxDynamicSharedMemorySize, LDS_BYTES) != hipSuccess) { fprintf(stderr, "kernel_launch: hipFuncSetAttribute failed\n"); grid = -1; return; }
        if (hipOccupancyMaxActiveBlocksPerMultiprocessor(&per_cu, (const void*)trunk_fwd, NTHREADS, LDS_BYTES) != hipSuccess || per_cu < 1) { fprintf(stderr, "kernel_launch: occupancy query says %d\n", per_cu); }
        (void)hipGetLastError();
        grid = cus;
    }
    if (grid < 0) return;
    (void)hipMemsetAsync((char*)d_ws + WS_CTL, 0, CTL_BYTES, stream);
    Args a{};
    for (int i = 0; i < 23; ++i) a.in[i] = (const float*)d_in[i];
    a.out = (float*)d_out; a.ws = (unsigned char*)d_ws;
#if N_LAUNCH_MODE == 1
    a.ph_lo = 0; a.ph_hi = NPHASE;
    hipLaunchKernelGGL(trunk_fwd, dim3(grid), dim3(NTHREADS), LDS_BYTES, stream, a);
#else
    for (int ph = 0; ph < NPHASE; ++ph) {
        if (ph == 12) continue;
        a.ph_lo = ph; a.ph_hi = ph + 1;
        hipLaunchKernelGGL(trunk_fwd, dim3(grid), dim3(NTHREADS), LDS_BYTES, stream, a);
    }
#endif
}
```
